# Optimizing an MI355X kernel written in HIP

```python
import math
import jax, jax.numpy as jnp
from jax import lax
import numpy as np

D_MODEL = 1024
BATCH = 2
SEQ = 8192
DEPTH = 1

MIX_WIDTH = D_MODEL
WIDTH_A = MIX_WIDTH // 2
WIDTH_B = MIX_WIDTH - WIDTH_A
DIFF_HEAD_DIM = 64
DIFF_V_DIM = 2 * DIFF_HEAD_DIM
N_HEADS_A = WIDTH_A // DIFF_V_DIM
HEAD_DIM_B = 64
N_HEADS_B = WIDTH_B // HEAD_DIM_B
N_KV_B = 2
GQA_GROUP = N_HEADS_B // N_KV_B
GRID_W = 64
ROPE_THETA = 10000.0
ROT_HALF = HEAD_DIM_B // 2
Q_BLOCK = 128
NORM_EPS = 1e-6
PROJ_SIZES = (
    N_HEADS_A * 2 * DIFF_HEAD_DIM,
    N_HEADS_A * 2 * DIFF_HEAD_DIM,
    WIDTH_A,
    WIDTH_A,
    N_HEADS_B * HEAD_DIM_B,
    N_KV_B * HEAD_DIM_B,
    N_KV_B * HEAD_DIM_B,
    WIDTH_B,
)
PROJ_OUT = sum(PROJ_SIZES)
PROJ_SPLITS = tuple(int(v) for v in np.cumsum(PROJ_SIZES)[:-1])

kernel_name = "hybrid_diffattn_gqa_axialrope_adaln"


def rmsnorm(x, w):
    xf = x.astype(jnp.float32)
    y = xf * lax.rsqrt(jnp.mean(xf * xf, axis=-1, keepdims=True) + NORM_EPS)
    return (y * w.astype(jnp.float32)).astype(x.dtype)


def lambda_init_for(layer_idx):
    return 0.8 - 0.6 * math.exp(-0.3 * layer_idx)


def alibi_slopes(n_heads):
    s = 2.0 ** (-8.0 * np.arange(1, n_heads + 1) / n_heads)
    return jnp.asarray(s, dtype=jnp.float32)


def axial_rope_tables(rows):
    row = jnp.repeat(jnp.arange(rows), GRID_W).astype(jnp.float32)
    col = jnp.tile(jnp.arange(GRID_W), rows).astype(jnp.float32)
    freqs = 1.0 / (ROPE_THETA ** (jnp.arange(ROT_HALF // 2, dtype=jnp.float32) * 2.0 / ROT_HALF))
    ang_r = row[:, None] * freqs[None, :]
    ang_c = col[:, None] * freqs[None, :]
    return jnp.cos(ang_r), jnp.sin(ang_r), jnp.cos(ang_c), jnp.sin(ang_c)


def rotate(x, cos, sin):
    x1, x2 = jnp.split(x, 2, axis=-1)
    cos = cos.astype(x.dtype)
    sin = sin.astype(x.dtype)
    return jnp.concatenate([x1 * cos - x2 * sin, x2 * cos + x1 * sin], axis=-1)


def axial_rope(x, tables):
    cos_r, sin_r, cos_c, sin_c = tables
    xr, xc = jnp.split(x, 2, axis=-1)
    return jnp.concatenate([rotate(xr, cos_r, sin_r), rotate(xc, cos_c, sin_c)], axis=-1)


def hybrid_layer(x, c, layer_idx, rope_tables, slopes, w_ada, b_ada, norm_w, w_in,
                 lq1, lk1, lq2, lk2, subln_w, q_norm_w, k_norm_w, w_out):
    bsz, seq, _ = x.shape
    nblk = seq // Q_BLOCK
    lam_init = lambda_init_for(layer_idx)

    mod = jax.nn.silu(c) @ w_ada + b_ada
    shift, scale, gate = jnp.split(mod, 3, axis=-1)
    h = rmsnorm(x, norm_w) * (1.0 + scale[:, None, :]) + shift[:, None, :]

    proj = h @ w_in
    qa, ka, va, ga, qb, kb, vb, gb = jnp.split(proj, PROJ_SPLITS, axis=-1)

    qa = qa.reshape(bsz, seq, N_HEADS_A, 2, DIFF_HEAD_DIM).transpose(0, 2, 3, 1, 4)
    ka = ka.reshape(bsz, seq, N_HEADS_A, 2, DIFF_HEAD_DIM).transpose(0, 2, 3, 1, 4)
    va = va.reshape(bsz, seq, N_HEADS_A, DIFF_V_DIM).transpose(0, 2, 1, 3)
    lam = (jnp.exp(jnp.sum(lq1.astype(jnp.float32) * lk1.astype(jnp.float32)))
           - jnp.exp(jnp.sum(lq2.astype(jnp.float32) * lk2.astype(jnp.float32)))
           + lam_init)

    qb = qb.reshape(bsz, seq, N_KV_B, GQA_GROUP, HEAD_DIM_B).transpose(0, 2, 3, 1, 4)
    kb = kb.reshape(bsz, seq, N_KV_B, HEAD_DIM_B).transpose(0, 2, 1, 3)
    vb = vb.reshape(bsz, seq, N_KV_B, HEAD_DIM_B).transpose(0, 2, 1, 3)
    qb = axial_rope(rmsnorm(qb, q_norm_w), rope_tables)
    kb = axial_rope(rmsnorm(kb, k_norm_w), rope_tables)

    qa_blk = jnp.moveaxis(qa.reshape(bsz, N_HEADS_A, 2, nblk, Q_BLOCK, DIFF_HEAD_DIM), 3, 0)
    qb_blk = jnp.moveaxis(qb.reshape(bsz, N_KV_B, GQA_GROUP, nblk, Q_BLOCK, HEAD_DIM_B), 3, 0)
    kpos = jnp.arange(seq, dtype=jnp.float32)
    scale_a = 1.0 / math.sqrt(DIFF_HEAD_DIM)
    scale_b = 1.0 / math.sqrt(HEAD_DIM_B)

    def query_block(args):
        qa_i, qb_i, i = args
        qpos = (i * Q_BLOCK + jnp.arange(Q_BLOCK)).astype(jnp.float32)
        dist = jnp.abs(qpos[:, None] - kpos[None, :])
        sa = (jnp.einsum('bhmqd,bhmkd->bhmqk', qa_i, ka).astype(jnp.float32) * scale_a
              - slopes[:, None, None, None] * dist)
        pa = jax.nn.softmax(sa, axis=-1)
        diff = pa[:, :, 0] - lam * pa[:, :, 1]
        oa = jnp.einsum('bhqk,bhkd->bhqd', diff.astype(va.dtype), va)
        sb = jnp.einsum('bgrqd,bgkd->bgrqk', qb_i, kb).astype(jnp.float32) * scale_b
        pb = jax.nn.softmax(sb, axis=-1)
        ob = jnp.einsum('bgrqk,bgkd->bgrqd', pb.astype(vb.dtype), vb)
        return oa, ob

    oa, ob = lax.map(query_block, (qa_blk, qb_blk, jnp.arange(nblk)))
    oa = oa.transpose(1, 0, 3, 2, 4).reshape(bsz, seq, N_HEADS_A, DIFF_V_DIM)
    oa = (rmsnorm(oa, subln_w) * (1.0 - lam_init)).reshape(bsz, seq, WIDTH_A)
    ob = ob.transpose(1, 0, 4, 2, 3, 5).reshape(bsz, seq, WIDTH_B)

    y = jnp.concatenate([oa * jax.nn.silu(ga), ob * jax.nn.silu(gb)], axis=-1) @ w_out
    return x + gate[:, None, :] * y


def setup_inputs(seed: int = 0) -> dict:
    key = jax.random.key(seed)
    ks = jax.random.split(key, 16)
    f32 = jnp.float32
    D = D_MODEL
    nrm = lambda k, shape, s: jax.random.normal(k, shape, f32) * s
    return {
        "x": nrm(ks[0], (BATCH, SEQ, D), 1.0),
        "c": nrm(ks[1], (BATCH, D), 1.0),
        "w_ada": nrm(ks[2], (DEPTH, D, 3 * D), 0.5 * D ** -0.5),
        "b_ada": nrm(ks[3], (DEPTH, 3 * D), 0.02),
        "norm_w": 1.0 + nrm(ks[4], (DEPTH, D), 0.02),
        "w_in": nrm(ks[5], (DEPTH, D, PROJ_OUT), D ** -0.5),
        "lambda_q1": nrm(ks[6], (DEPTH, DIFF_HEAD_DIM), 0.1),
        "lambda_k1": nrm(ks[7], (DEPTH, DIFF_HEAD_DIM), 0.1),
        "lambda_q2": nrm(ks[8], (DEPTH, DIFF_HEAD_DIM), 0.1),
        "lambda_k2": nrm(ks[9], (DEPTH, DIFF_HEAD_DIM), 0.1),
        "subln_w": 1.0 + nrm(ks[10], (DEPTH, DIFF_V_DIM), 0.02),
        "q_norm_w": 1.0 + nrm(ks[11], (DEPTH, HEAD_DIM_B), 0.02),
        "k_norm_w": 1.0 + nrm(ks[12], (DEPTH, HEAD_DIM_B), 0.02),
        "w_out": nrm(ks[13], (DEPTH, MIX_WIDTH, D), MIX_WIDTH ** -0.5),
        "final_norm_w": 1.0 + nrm(ks[14], (D,), 0.02),
    }


def reference(x, c, w_ada, b_ada, norm_w, w_in, lambda_q1, lambda_k1, lambda_q2, lambda_k2,
              subln_w, q_norm_w, k_norm_w, w_out, final_norm_w):
    seq = x.shape[1]
    rows = seq // GRID_W
    rope_tables = axial_rope_tables(rows)
    slopes = alibi_slopes(N_HEADS_A)
    for l in range(DEPTH):
        x = hybrid_layer(x, c, l, rope_tables, slopes, w_ada[l], b_ada[l], norm_w[l], w_in[l],
                         lambda_q1[l], lambda_k1[l], lambda_q2[l], lambda_k2[l], subln_w[l],
                         q_norm_w[l], k_norm_w[l], w_out[l])
    return rmsnorm(x, final_norm_w)
```

```cpp
#include <hip/hip_runtime.h>
#include <cstdio>
#include <cstdint>

namespace pg8 {
#define PG8_LAS __attribute__((address_space(3)))
typedef unsigned short bf16_t;
typedef short bf16x8 __attribute__((ext_vector_type(8)));
typedef float f32x4 __attribute__((ext_vector_type(4)));
typedef unsigned u32x4 __attribute__((ext_vector_type(4)));
constexpr int BM = 256, BK = 64, HALF = 128, HTB = HALF * BK * 2  , STAGE_BYTES = 8 * HTB, NXCD = 8, WGM = 8;

__host__ __device__ __forceinline__ int lds_byte(int r, int c) { const int st = (r >> 4) * 2 + (c >> 5), rr = r & 15, cc = c & 31, ob = rr * 64 + cc * 2; return st * 1024 + (ob ^ (((ob >> 9) & 1) << 5)); }
__host__ __device__ __forceinline__ void stage_rc(int b, int& R, int& C) { const int st = b / 1024, sb = b % 1024, swz = sb ^ (((sb >> 9) & 1) << 5); R = (st >> 1) * 16 + swz / 64; C = (st & 1) * 32 + (swz % 64) / 2; }
__host__ __device__ __forceinline__ int perm32(int rho) { const int n = rho >> 4, i = rho & 15; return 8 * (i >> 2) + 4 * n + (i & 3); }

struct Unit { int pm, pn; };
struct Gemm { const bf16_t* A; const bf16_t* Bt; int M, N, K; };

struct StaticOrder {
    int nM, nN, nwg, G, c;
    __host__ __device__ void init(int M, int N, int G_, int c_) { nM = M / BM; nN = N / BM; nwg = nM * nN; G = G_; c = c_; }
    __host__ __device__ bool next(int i, Unit& u) const {
        const long L = (long)i * G + c; if (L >= nwg) return false;
        int wgid = (int)L; { const int q = nwg / NXCD, r = nwg % NXCD, xcd = wgid % NXCD, off = wgid / NXCD; wgid = (xcd < r ? xcd * (q + 1) : r * (q + 1) + (xcd - r) * q) + off; }
        const int nig = WGM * nN, gid = wgid / nig, fm = gid * WGM, gsz = (nM - fm) < WGM ? (nM - fm) : WGM;
        u.pm = fm + ((wgid % nig) % gsz); u.pn = (wgid % nig) / gsz; return true;
    }
    __device__ __forceinline__ void a_ready(const Unit&) const {}
    __device__ __forceinline__ void done(const Unit&) const {}
};

__device__ __forceinline__ unsigned cvt_pk_bf16(float lo, float hi) { unsigned r; asm volatile("v_cvt_pk_bf16_f32 %0, %1, %2" : "=v"(r) : "v"(lo), "v"(hi)); return r; }
typedef float f32x2 __attribute__((ext_vector_type(2)));

__device__ __forceinline__ float silu_f(float v) { return v * __builtin_amdgcn_rcpf(1.f + __builtin_amdgcn_exp2f(-1.4426950408889634f * v)); }
struct EpiProj {
    static constexpr bool PERM = true, AFTER_DRAIN = false;
    bf16_t *QA, *KA, *VA, *GA, *VB, *GB; float *QBR, *KBR; float qscale;
    __device__ __forceinline__ void operator()(const f32x4 (&acc)[2][2][4][2], const Unit& u, int wr, int wc, int fr, int fq) const {
        const int row0 = u.pm * BM + wr * 64 + fr, cin = wc * 32 + 8 * fq;
#pragma unroll
        for (int bj = 0; bj < 2; ++bj) {
            const int blk = u.pn * 2 + bj;
            int mode = 0, ld = 512, c0 = 0; bf16_t* d16 = nullptr; float* d32 = nullptr;
            if (blk < 4)       { mode = 1; d16 = QA; c0 = blk * 128 + cin; }
            else if (blk < 8)  { mode = 0; d16 = KA; c0 = (blk - 4) * 128 + cin; }
            else if (blk < 12) { mode = 0; d16 = VA; c0 = (blk - 8) * 128 + cin; }
            else if (blk < 16) { mode = 2; d16 = GA; c0 = (blk - 12) * 128 + cin; }
            else if (blk < 20) { mode = 3; d32 = QBR; c0 = (blk - 16) * 128 + cin; }
            else if (blk == 20) { mode = 3; d32 = KBR; ld = 128; c0 = cin; }
            else if (blk == 21) { mode = 0; d16 = VB; ld = 128; c0 = cin; }
            else               { mode = 2; d16 = GB; c0 = (blk - 22) * 128 + cin; }
#pragma unroll
            for (int ai = 0; ai < 2; ++ai)
#pragma unroll
                for (int m = 0; m < 4; ++m) {
                    const size_t off = (size_t)(row0 + ai * HALF + m * 16) * ld + c0;
                    f32x4 v0 = acc[ai][bj][m][0], v1 = acc[ai][bj][m][1];
                    if (mode == 3) { *(f32x4*)(d32 + off) = v0; *(f32x4*)(d32 + off + 4) = v1; }
                    else {
                        if (mode == 1) { v0 = v0 * qscale; v1 = v1 * qscale; }
                        if (mode == 2) { v0 = (f32x4){silu_f(v0[0]), silu_f(v0[1]), silu_f(v0[2]), silu_f(v0[3])}; v1 = (f32x4){silu_f(v1[0]), silu_f(v1[1]), silu_f(v1[2]), silu_f(v1[3])}; }
                        u32x4 w; w.x = cvt_pk_bf16(v0[0], v0[1]); w.y = cvt_pk_bf16(v0[2], v0[3]); w.z = cvt_pk_bf16(v1[0], v1[1]); w.w = cvt_pk_bf16(v1[2], v1[3]);
                        *(u32x4*)(d16 + off) = w;
                    }
                }
        }
    }
};
struct EpiOut {
    static constexpr bool PERM = true, AFTER_DRAIN = false;
    const float* x; float* out; const float* modf;
    __device__ __forceinline__ void operator()(const f32x4 (&acc)[2][2][4][2], const Unit& u, int wr, int wc, int fr, int fq) const {
        const int row0 = u.pm * BM + wr * 64 + fr, b = u.pm >> 5;
#pragma unroll
        for (int bj = 0; bj < 2; ++bj) {
            const int col0 = u.pn * BM + bj * HALF + wc * 32 + 8 * fq;
            const f32x4 g0 = *(const f32x4*)(modf + b * 3072 + 2048 + col0), g1 = *(const f32x4*)(modf + b * 3072 + 2048 + col0 + 4);
#pragma unroll
            for (int ai = 0; ai < 2; ++ai)
#pragma unroll
                for (int m = 0; m < 4; ++m) {
                    const size_t off = (size_t)(row0 + ai * HALF + m * 16) * 1024 + col0;
                    const f32x4 x0 = *(const f32x4*)(x + off), x1 = *(const f32x4*)(x + off + 4);
                    *(f32x4*)(out + off) = x0 + g0 * acc[ai][bj][m][0]; *(f32x4*)(out + off + 4) = x1 + g1 * acc[ai][bj][m][1];
                }
        }
    }
};

template <class Epi, class Sched, bool ALIGN_EPI = false, bool SP2 = false>
__device__ __forceinline__ void gemm_phase(PG8_LAS unsigned char* lds, const Gemm g, const Sched& S, const Epi& E) {
    const int tid = threadIdx.x, wid = __builtin_amdgcn_readfirstlane(tid >> 6), lane = tid & 63, wr = wid >> 2, wc = wid & 3, fr = lane & 15, fq = lane >> 4;
    const int K = g.K, nt = K / BK;
    unsigned voffA[2], voffB[2];
#pragma unroll
    for (int i = 0; i < 2; ++i) { int R, C; stage_rc(tid * 16 + i * 8192, R, C); const int Rb = Epi::PERM ? ((R & ~31) + perm32(R & 31)) : R;
        voffA[i] = (unsigned)(R * K + C) * 2u; voffB[i] = (unsigned)(Rb * K + C) * 2u; }
    const size_t kstep = (size_t)(BK * 2);
    const size_t hstep = (size_t)HALF * K * 2;
    const size_t tstep = 2 * hstep;
    const unsigned ldsw = (unsigned)wid * 1024u;
    const int aoff = lds_byte(wr * 64 + fr, fq * 8), boff = lds_byte(wc * 32 + fr, fq * 8);
#define PG8_SA(b, h) (((b) * 2 + (h)) * HTB)
#define PG8_SB(b, h) ((4 + (b) * 2 + (h)) * HTB)
#define PG8_STAGE(bufoff, gbase, voff) do { _Pragma("unroll") for (int _i = 0; _i < 2; ++_i) \
        __builtin_amdgcn_global_load_lds((const unsigned*)((const char*)(gbase) + (voff)[_i]), (PG8_LAS unsigned*)(lds + (bufoff) + ldsw + _i * 8192), 16, 0, 0); } while (0)
#define PG8_LDA(dst, b, h) do { _Pragma("unroll") for (int m = 0; m < 4; ++m) _Pragma("unroll") for (int k = 0; k < 2; ++k) dst[m][k] = *(const PG8_LAS bf16x8*)(lds + PG8_SA(b, h) + aoff + m * 2048 + k * 1024); } while (0)
#define PG8_LDB(dst, b, h) do { _Pragma("unroll") for (int n = 0; n < 2; ++n) _Pragma("unroll") for (int k = 0; k < 2; ++k) dst[n][k] = *(const PG8_LAS bf16x8*)(lds + PG8_SB(b, h) + boff + n * 2048 + k * 1024); } while (0)
#define PG8_MMA(ai, bj, At, Bt) do { __builtin_amdgcn_s_setprio(1); _Pragma("unroll") for (int m = 0; m < 4; ++m) _Pragma("unroll") for (int n = 0; n < 2; ++n) _Pragma("unroll") for (int k = 0; k < 2; ++k) \
        acc[ai][bj][m][n] = __builtin_amdgcn_mfma_f32_16x16x32_bf16(Bt[n][k], At[m][k], acc[ai][bj][m][n], 0, 0, 0); __builtin_amdgcn_s_setprio(0); } while (0)
#define PG8_WAIT_V(n) asm volatile("s_waitcnt vmcnt(" #n ")" ::: "memory")
#define PG8_WAIT_L(n) asm volatile("s_waitcnt lgkmcnt(" #n ")" ::: "memory")
#define PG8_BAR __builtin_amdgcn_s_barrier()
#define PG8_SCHED __builtin_amdgcn_sched_barrier(0)
    Unit cur, nxt; int ui = 0;
    if (!S.next(0, cur)) return;
    f32x4 acc[2][2][4][2];
#pragma unroll
    for (int a = 0; a < 2; ++a)
#pragma unroll
        for (int b = 0; b < 2; ++b)
#pragma unroll
            for (int m = 0; m < 4; ++m)
#pragma unroll
                for (int n = 0; n < 2; ++n) acc[a][b][m][n] = (f32x4){0.f, 0.f, 0.f, 0.f};
    bf16x8 At[4][2], B0[2][2], B1[2][2];
    const char* cA = (const char*)g.A + (size_t)cur.pm * tstep; const char* cB = (const char*)g.Bt + (size_t)cur.pn * tstep;
    S.a_ready(cur);
    if constexpr (SP2) {
        PG8_STAGE(PG8_SB(0, 0), cB, voffB); PG8_STAGE(PG8_SB(0, 1), cB + hstep, voffB); PG8_STAGE(PG8_SA(0, 0), cA, voffA); PG8_STAGE(PG8_SA(0, 1), cA + hstep, voffA);
        if (wr == 1) PG8_BAR;
        PG8_WAIT_V(2); PG8_BAR;
        PG8_STAGE(PG8_SB(1, 0), cB + kstep, voffB); PG8_STAGE(PG8_SA(1, 0), cA + kstep, voffA); PG8_STAGE(PG8_SB(1, 1), cB + hstep + kstep, voffB);
        PG8_WAIT_V(6); PG8_BAR;
    } else {
        PG8_STAGE(PG8_SB(0, 0), cB, voffB); PG8_STAGE(PG8_SA(0, 0), cA, voffA); PG8_STAGE(PG8_SB(0, 1), cB + hstep, voffB); PG8_STAGE(PG8_SA(0, 1), cA + hstep, voffA);
        if (wr == 1) PG8_BAR;
        PG8_WAIT_V(4); PG8_BAR;
        PG8_STAGE(PG8_SB(1, 0), cB + kstep, voffB); PG8_STAGE(PG8_SA(1, 0), cA + kstep, voffA); PG8_STAGE(PG8_SB(1, 1), cB + hstep + kstep, voffB);
        PG8_WAIT_V(6); PG8_BAR;
    }
    for (;;) {
        const bool has_next = S.next(ui + 1, nxt);
        const char* nA = has_next ? (const char*)g.A + (size_t)nxt.pm * tstep : cA; const char* nB = has_next ? (const char*)g.Bt + (size_t)nxt.pn * tstep : cB;
        for (int t = 0; t < nt; t += 2) {
            const bool last = (t == nt - 2);
            const char* a1 = cA + (size_t)(t + 1) * kstep;
            const char* a2 = last ? nA : cA + (size_t)(t + 2) * kstep; const char* b2 = last ? nB : cB + (size_t)(t + 2) * kstep;
            const char* a3 = a2 + kstep; const char* b3 = b2 + kstep;
            if (last && has_next) S.a_ready(nxt);
            if constexpr (SP2) {
            PG8_LDB(B0, 0, 0); PG8_LDB(B1, 0, 1); PG8_SCHED; PG8_LDA(At, 0, 0); PG8_STAGE(PG8_SA(1, 1), a1 + hstep, voffA);
            PG8_WAIT_V(8); PG8_WAIT_L(0); PG8_BAR; PG8_MMA(0, 0, At, B0); PG8_MMA(0, 1, At, B1); PG8_BAR; PG8_SCHED;
            PG8_LDA(At, 0, 1); PG8_STAGE(PG8_SB(0, 0), b2, voffB); PG8_STAGE(PG8_SB(0, 1), b2 + hstep, voffB); PG8_STAGE(PG8_SA(0, 0), a2, voffA);
            PG8_WAIT_V(8); PG8_WAIT_L(0); PG8_BAR; PG8_MMA(1, 0, At, B0); PG8_MMA(1, 1, At, B1); PG8_BAR; PG8_SCHED;
            PG8_LDB(B0, 1, 0); PG8_LDB(B1, 1, 1); PG8_SCHED; PG8_LDA(At, 1, 0); PG8_STAGE(PG8_SA(0, 1), a2 + hstep, voffA);
            PG8_WAIT_V(8); PG8_WAIT_L(0); PG8_BAR; PG8_MMA(0, 0, At, B0); PG8_MMA(0, 1, At, B1); PG8_BAR; PG8_SCHED;
            PG8_LDA(At, 1, 1); PG8_STAGE(PG8_SB(1, 0), b3, voffB); PG8_STAGE(PG8_SB(1, 1), b3 + hstep, voffB); PG8_STAGE(PG8_SA(1, 0), a3, voffA);
            PG8_WAIT_V(8); PG8_WAIT_L(0); PG8_BAR; PG8_MMA(1, 0, At, B0); PG8_MMA(1, 1, At, B1); PG8_BAR; PG8_SCHED;
            } else {
            PG8_LDB(B0, 0, 0); PG8_SCHED; PG8_LDA(At, 0, 0); PG8_STAGE(PG8_SA(1, 1), a1 + hstep, voffA);
            PG8_WAIT_L(8); PG8_BAR; PG8_WAIT_L(0); PG8_MMA(0, 0, At, B0); PG8_BAR; PG8_SCHED;
            PG8_LDB(B1, 0, 1); PG8_STAGE(PG8_SB(0, 0), b2, voffB);
            PG8_BAR; PG8_WAIT_L(0); PG8_MMA(0, 1, At, B1); PG8_BAR;
            PG8_LDA(At, 0, 1); PG8_STAGE(PG8_SA(0, 0), a2, voffA);
            PG8_BAR; PG8_WAIT_L(0); PG8_MMA(1, 0, At, B0); PG8_BAR; PG8_SCHED;
            PG8_STAGE(PG8_SB(0, 1), b2 + hstep, voffB);
            PG8_WAIT_V(6); PG8_BAR; PG8_MMA(1, 1, At, B1); PG8_BAR;
            PG8_LDB(B0, 1, 0); PG8_SCHED; PG8_LDA(At, 1, 0); PG8_STAGE(PG8_SA(0, 1), a2 + hstep, voffA);
            PG8_WAIT_L(8); PG8_BAR; PG8_WAIT_L(0); PG8_MMA(0, 0, At, B0); PG8_BAR; PG8_SCHED;
            PG8_LDB(B1, 1, 1); PG8_STAGE(PG8_SB(1, 0), b3, voffB);
            PG8_BAR; PG8_WAIT_L(0); PG8_MMA(0, 1, At, B1); PG8_BAR;
            PG8_LDA(At, 1, 1); PG8_STAGE(PG8_SA(1, 0), a3, voffA);
            PG8_BAR; PG8_WAIT_L(0); PG8_MMA(1, 0, At, B0); PG8_BAR; PG8_SCHED;
            PG8_STAGE(PG8_SB(1, 1), b3 + hstep, voffB);
            PG8_WAIT_V(6); PG8_BAR; PG8_MMA(1, 1, At, B1); PG8_BAR;
            }
        }
        if constexpr (ALIGN_EPI) { if (wr == 0) PG8_BAR; }
        if constexpr (!Epi::AFTER_DRAIN) { E(acc, cur, wr, wc, fr, fq); S.done(cur); }
        if (!has_next) break;
#pragma unroll
        for (int a = 0; a < 2; ++a)
#pragma unroll
            for (int b = 0; b < 2; ++b)
#pragma unroll
                for (int m = 0; m < 4; ++m)
#pragma unroll
                    for (int n = 0; n < 2; ++n) acc[a][b][m][n] = (f32x4){0.f, 0.f, 0.f, 0.f};
        cur = nxt; cA = nA; cB = nB; ++ui;
        if constexpr (ALIGN_EPI) { if (wr == 1) PG8_BAR; }
    }
    PG8_WAIT_V(0);
    if constexpr (!ALIGN_EPI) { if (wr == 0) PG8_BAR; }
    PG8_BAR;
    if constexpr (Epi::AFTER_DRAIN) { E.fused(acc, cur, wr, wc, fr, fq, lds, wid, lane); S.done(cur); }
#undef PG8_SA
#undef PG8_SB
#undef PG8_STAGE
#undef PG8_LDA
#undef PG8_LDB
#undef PG8_MMA
#undef PG8_WAIT_V
#undef PG8_WAIT_L
#undef PG8_BAR
#undef PG8_SCHED
}
}

#define LAS __attribute__((address_space(3)))
typedef unsigned short bf16_t;
typedef float f32x4 __attribute__((ext_vector_type(4)));
typedef float f32x2 __attribute__((ext_vector_type(2)));
typedef unsigned v4u __attribute__((ext_vector_type(4)));

constexpr int BATCH = 2, SEQ = 8192, DM = 1024, M = BATCH * SEQ, NPROJ = 3328;
constexpr float NORM_EPS = 1e-6f, LOG2E = 1.4426950408889634f;
constexpr float C2 = 0.125f * LOG2E;
constexpr float LAM_INIT = 0.2f;

__device__ __forceinline__ unsigned cvtpk(float lo, float hi) { typedef __bf16 b2 __attribute__((ext_vector_type(2))); f32x2 v = {lo, hi}; b2 b = __builtin_convertvector(v, b2); return __builtin_bit_cast(unsigned, b); }
__device__ __forceinline__ bf16_t f2bf(float f) { return (bf16_t)(cvtpk(f, 0.f) & 0xffffu); }
__device__ __forceinline__ float bf2f(bf16_t v) { return __uint_as_float((unsigned)v << 16); }
__device__ __forceinline__ float wave_sum(float v) {
#pragma unroll
    for (int o = 1; o < 64; o <<= 1) v += __shfl_xor(v, o);
    return v;
}

#ifndef ATT_BODY_A
#define ATT_BODY_A attn_body
#endif
#ifndef ATT_BODY_B
#define ATT_BODY_B attn_body_p
#endif
namespace att {
typedef short bf16x8 __attribute__((ext_vector_type(8)));
typedef short s16x4 __attribute__((ext_vector_type(4)));
typedef float f32x16 __attribute__((ext_vector_type(16)));
constexpr int NW = 8, QBLK = 32, KVBLK = 64, NT = SEQ / KVBLK;
constexpr float THR = 8.f;
constexpr int SHM_V = 16384, SHM_K = 8192, LDS_V = 0, LDS_K = 2 * SHM_V, LDS_WS = 131072 + 8192;
#define SBAR() __builtin_amdgcn_sched_barrier(0)
#define KSWZ64(row, colB) ((row) * 128 + ((colB) ^ ((((row) >> 1) & 7) << 4)))
#define MFMA32(a, b, c) __builtin_amdgcn_mfma_f32_32x32x16_bf16(a, b, c, 0, 0, 0)
#define MX3(a, b, c) __builtin_fmaxf(__builtin_fmaxf((a), (b)), (c))
__device__ __forceinline__ int crow(int r, int hi) { return (r & 3) + 8 * (r >> 2) + 4 * hi; }
template <int NCB> __device__ __forceinline__ int v_st(int k, int c) { return ((k >> 3) * NCB + (c >> 5)) * 512 + ((k & 7) * 32 + (c & 31)) * 2; }
__device__ __forceinline__ int v_rd_base(int lane) { return ((lane & 3) << 3) | (((lane >> 2) & 3) << 6) | (((lane >> 4) & 1) << 5) | (((lane >> 5) & 1) << 8); }
template <int OFF> __device__ __forceinline__ s16x4 tr_read(unsigned vb) { s16x4 r; asm volatile("ds_read_b64_tr_b16 %0, %1 offset:%2" : "=&v"(r) : "v"(vb), "i"(OFF) : "memory"); return r; }
template <int NCB, int D0> __device__ __forceinline__ void pv_one(f32x16& od, unsigned vb, bf16x8 pa0, bf16x8 pa1, bf16x8 pa2, bf16x8 pa3) {
#define VOFF(ks, half) (D0 * 512 + (2 * (ks) + (half)) * NCB * 512)
    const s16x4 l0 = tr_read<VOFF(0, 0)>(vb), h0 = tr_read<VOFF(0, 1)>(vb), l1 = tr_read<VOFF(1, 0)>(vb), h1 = tr_read<VOFF(1, 1)>(vb);
    const s16x4 l2 = tr_read<VOFF(2, 0)>(vb), h2 = tr_read<VOFF(2, 1)>(vb), l3 = tr_read<VOFF(3, 0)>(vb), h3 = tr_read<VOFF(3, 1)>(vb);
#undef VOFF
    asm volatile("s_waitcnt lgkmcnt(0)" ::: "memory"); SBAR();
#define PK(L, H) (bf16x8){L[0], L[1], L[2], L[3], H[0], H[1], H[2], H[3]}
    od = MFMA32(pa0, PK(l0, h0), od); od = MFMA32(pa1, PK(l1, h1), od); od = MFMA32(pa2, PK(l2, h2), od); od = MFMA32(pa3, PK(l3, h3), od);
#undef PK
}
__device__ __forceinline__ float rowmax(const f32x16& p0, const f32x16& p1) {
    float a = MX3(p0[0], p0[1], p1[0]), b = MX3(p0[2], p0[3], p1[1]); a = MX3(a, p1[2], p1[3]);
#pragma unroll
    for (int r = 4; r < 16; r += 4) { a = MX3(a, p0[r], p0[r + 1]); b = MX3(b, p0[r + 2], p0[r + 3]); a = MX3(a, p1[r], p1[r + 1]); b = MX3(b, p1[r + 2], p1[r + 3]); }
    float rm = __builtin_fmaxf(a, b);
    auto rr = __builtin_amdgcn_permlane32_swap(__float_as_uint(rm), __float_as_uint(rm), false, false);
    return __builtin_fmaxf(__uint_as_float(rr[0]), __uint_as_float(rr[1]));
}

template <int DV, bool ALIBI, int LDQ, int LDK, int LDV>
__device__ __forceinline__ void attn_body(const bf16_t* __restrict__ Qw, const bf16_t* __restrict__ Kh, const bf16_t* __restrict__ Vh, int qw0, int t0, float cal,
                                          f32x16 (&o)[DV / 32], float& l_out, LAS char* lds) {
    constexpr int NCB = DV / 32;
    int tid = threadIdx.x; asm volatile("" : "+v"(tid));
    const int lane = tid & 63, r32 = lane & 31, hi = lane >> 5; const int wid = __builtin_amdgcn_readfirstlane(tid >> 6);
    LAS char* V_lds = lds + LDS_V; LAS char* K_lds = lds + LDS_K;
    LAS float* al_l = (LAS float*)(lds + LDS_WS) + wid * 64 + 32;
    float mhat = 0.f, l_reg = 0.f;
#pragma unroll
    for (int d = 0; d < NCB; ++d) o[d] = f32x16{};
    bf16x8 qr[4];
#pragma unroll
    for (int d0 = 0; d0 < 4; ++d0) qr[d0] = *(const bf16x8*)(Qw + (size_t)r32 * LDQ + d0 * 16 + hi * 8);
    const int kr = tid >> 3, kc = (tid & 7) * 8, kst = KSWZ64(kr, kc * 2);
    const int vr = (DV == 64) ? (tid >> 3) : (tid >> 4), vc = (DV == 64) ? (tid & 7) * 8 : (tid & 15) * 8;
    const int vst0 = v_st<NCB>(vr, vc), vst1 = v_st<NCB>(32 + vr, vc);
    const unsigned vb0 = (unsigned)(uintptr_t)V_lds + (unsigned)v_rd_base(lane);
    const bf16_t* kg = Kh + (size_t)kr * LDK + kc; const bf16_t* vg = Vh + (size_t)vr * LDV + vc;
    bf16x8 sk, sv0, sv1;
#define TILE(i) (((i) + t0) & (NT - 1))
#define SLOAD(tl) do { const size_t k0_ = (size_t)(tl) * KVBLK; sk = *(const bf16x8*)(kg + k0_ * LDK); sv0 = *(const bf16x8*)(vg + k0_ * LDV); \
        if (DV == 128) sv1 = *(const bf16x8*)(vg + (k0_ + 32) * LDV); } while (0)
#define SWRITE(b) do { *(LAS bf16x8*)(K_lds + (b) * SHM_K + kst) = sk; *(LAS bf16x8*)(V_lds + (b) * SHM_V + vst0) = sv0; \
        if (DV == 128) *(LAS bf16x8*)(V_lds + (b) * SHM_V + vst1) = sv1; } while (0)
    float ncal = -cal; asm volatile("" : "+v"(ncal));
    const int qpos = qw0 + r32; const float c32 = 32.f * cal;
#define COMPUTE(b, tl, FIRST) do { f32x16 p0, p1; \
        if (ALIBI) { const float cdq = cal * (float)(qpos - 4 * hi - (tl) * KVBLK), nm = -mhat, e1_ = cdq - c32; \
            _Pragma("unroll") for (int r = 0; r < 16; ++r) { const float kf_ = (float)((r & 3) + 8 * (r >> 2)); \
                p0[r] = nm - __builtin_fabsf(__builtin_fmaf(ncal, kf_, cdq)); p1[r] = nm - __builtin_fabsf(__builtin_fmaf(ncal, kf_, e1_)); } } \
        { const LAS char* Ks_ = K_lds + (b) * SHM_K; \
          _Pragma("unroll") for (int d0 = 0; d0 < 4; ++d0) { const int cb = (d0 * 16 + hi * 8) * 2; \
            const bf16x8 b0 = *(const LAS bf16x8*)(Ks_ + KSWZ64(r32, cb)), b1 = *(const LAS bf16x8*)(Ks_ + KSWZ64(32 + r32, cb)); \
            if (d0 == 0 && !ALIBI) { const f32x16 z = f32x16{}; p0 = MFMA32(b0, qr[0], z); p1 = MFMA32(b1, qr[0], z); } else { p0 = MFMA32(b0, qr[d0], p0); p1 = MFMA32(b1, qr[d0], p1); } } } \
        const float rm_ = rowmax(p0, p1) - (ALIBI ? 0.f : mhat); float alpha_ = 1.f; bool resc_ = false; \
        if ((FIRST) || __any(rm_ > THR)) { const float dl_ = (FIRST) ? rm_ : __builtin_fmaxf(rm_, 0.f); mhat += dl_; \
            if (!(FIRST)) { alpha_ = __builtin_amdgcn_exp2f(-dl_); resc_ = true; } } \
        SUBEXP(p0, p1); \
        float ps_ = 0.f; _Pragma("unroll") for (int r = 0; r < 16; ++r) ps_ += p0[r]; _Pragma("unroll") for (int r = 0; r < 16; ++r) ps_ += p1[r]; \
        l_reg = l_reg * alpha_ + ps_; \
        const v4u w0 = {cvtpk(p0[0], p0[1]), cvtpk(p0[2], p0[3]), cvtpk(p0[4], p0[5]), cvtpk(p0[6], p0[7])}, w1 = {cvtpk(p0[8], p0[9]), cvtpk(p0[10], p0[11]), cvtpk(p0[12], p0[13]), cvtpk(p0[14], p0[15])}; \
        const v4u w2 = {cvtpk(p1[0], p1[1]), cvtpk(p1[2], p1[3]), cvtpk(p1[4], p1[5]), cvtpk(p1[6], p1[7])}, w3 = {cvtpk(p1[8], p1[9]), cvtpk(p1[10], p1[11]), cvtpk(p1[12], p1[13]), cvtpk(p1[14], p1[15])}; \
        const bf16x8 pa0 = __builtin_bit_cast(bf16x8, w0), pa1 = __builtin_bit_cast(bf16x8, w1), pa2 = __builtin_bit_cast(bf16x8, w2), pa3 = __builtin_bit_cast(bf16x8, w3); \
        if (resc_) { if (hi == 0) al_l[r32] = alpha_; asm volatile("s_waitcnt lgkmcnt(0)" ::: "memory"); \
            _Pragma("unroll") for (int r = 0; r < 16; ++r) { const float f_ = al_l[crow(r, hi)]; _Pragma("unroll") for (int d = 0; d < NCB; ++d) o[d][r] *= f_; } } \
        const unsigned vb_ = vb0 + (b) * SHM_V; pv_one<NCB, 0>(o[0], vb_, pa0, pa1, pa2, pa3); pv_one<NCB, 1>(o[1], vb_, pa0, pa1, pa2, pa3); \
        if constexpr (NCB == 4) { pv_one<NCB, 2>(o[2], vb_, pa0, pa1, pa2, pa3); pv_one<NCB, 3>(o[3], vb_, pa0, pa1, pa2, pa3); } } while (0)
#define SUBEXP(P0, P1) do { const float s_ = ALIBI ? (mhat - mh_old_) : mhat; \
        _Pragma("unroll") for (int r = 0; r < 16; ++r) { P0[r] = __builtin_amdgcn_exp2f(P0[r] - s_); P1[r] = __builtin_amdgcn_exp2f(P1[r] - s_); } } while (0)
    float mh_old_ = 0.f;
    SLOAD(TILE(0)); asm volatile("s_waitcnt vmcnt(0)" ::: "memory"); SWRITE(0); SLOAD(TILE(1)); __syncthreads();
    for (int i = 0; i < NT; i += 2) {
        SWRITE(1); if (i + 2 < NT) SLOAD(TILE(i + 2));
        mh_old_ = mhat;
        COMPUTE(0, TILE(i), (i == 0));
        __syncthreads();
        if (i + 2 < NT) { SWRITE(0); if (i + 3 < NT) SLOAD(TILE(i + 3)); }
        mh_old_ = mhat;
        COMPUTE(1, TILE(i + 1), false);
        __syncthreads();
    }
    { auto rr = __builtin_amdgcn_permlane32_swap(__float_as_uint(l_reg), __float_as_uint(l_reg), false, false); l_out = __uint_as_float(rr[0]) + __uint_as_float(rr[1]); }
#undef TILE
#undef SLOAD
#undef SWRITE
#undef COMPUTE
#undef SUBEXP
}

template <int DV, bool ALIBI, int LDQ, int LDK, int LDV>
__device__ __forceinline__ void attn_body_p(const bf16_t* __restrict__ Qw, const bf16_t* __restrict__ Kh, const bf16_t* __restrict__ Vh, int qw0, int t0, float cal,
                                            f32x16 (&o)[DV / 32], float& l_out, LAS char* lds) {
    constexpr int NCB = DV / 32, PLDS_K = 3 * SHM_V;
    int tid = threadIdx.x; asm volatile("" : "+v"(tid));
    const int lane = tid & 63, r32 = lane & 31, hi = lane >> 5; const int wid = __builtin_amdgcn_readfirstlane(tid >> 6);
    LAS char* V_lds = lds; LAS char* K_lds = lds + PLDS_K;
    LAS float* al_l = (LAS float*)(lds + LDS_WS) + wid * 64 + 32;
    float mhat = 0.f, l_reg = 0.f;
#pragma unroll
    for (int d = 0; d < NCB; ++d) o[d] = f32x16{};
    bf16x8 qr[4];
#pragma unroll
    for (int d0 = 0; d0 < 4; ++d0) qr[d0] = *(const bf16x8*)(Qw + (size_t)r32 * LDQ + d0 * 16 + hi * 8);
    const int kr = tid >> 3, kc = (tid & 7) * 8, kst = KSWZ64(kr, kc * 2);
    const int vr = (DV == 64) ? (tid >> 3) : (tid >> 4), vc = (DV == 64) ? (tid & 7) * 8 : (tid & 15) * 8;
    const int vst0 = v_st<NCB>(vr, vc), vst1 = v_st<NCB>(32 + vr, vc);
    const unsigned vb0 = (unsigned)(uintptr_t)V_lds + (unsigned)v_rd_base(lane);
    const bf16_t* kg = Kh + (size_t)kr * LDK + kc; const bf16_t* vg = Vh + (size_t)vr * LDV + vc;
    bf16x8 sk, sv0, sv1;
#define TILE(i) (((i) + t0) & (NT - 1))
#define SLOAD(tl) do { const size_t k0_ = (size_t)(tl) * KVBLK; sk = *(const bf16x8*)(kg + k0_ * LDK); sv0 = *(const bf16x8*)(vg + k0_ * LDV); \
        if (DV == 128) sv1 = *(const bf16x8*)(vg + (k0_ + 32) * LDV); } while (0)
#define SWRITE(kb, voff) do { *(LAS bf16x8*)(K_lds + (kb) * SHM_K + kst) = sk; *(LAS bf16x8*)(V_lds + (voff) + vst0) = sv0; \
        if (DV == 128) *(LAS bf16x8*)(V_lds + (voff) + vst1) = sv1; } while (0)
    float ncal = -cal; asm volatile("" : "+v"(ncal));
    const int qpos = qw0 + r32; const float c32 = 32.f * cal;
#define INITC(P0, P1, tl) do { if (ALIBI) { const float cdq = cal * (float)(qpos - 4 * hi - (tl) * KVBLK), nm = -mhat, e1_ = cdq - c32; \
        _Pragma("unroll") for (int r = 0; r < 16; ++r) { const float kf_ = (float)((r & 3) + 8 * (r >> 2)); \
            P0[r] = nm - __builtin_fabsf(__builtin_fmaf(ncal, kf_, cdq)); P1[r] = nm - __builtin_fabsf(__builtin_fmaf(ncal, kf_, e1_)); } } } while (0)
#define QKT(P0, P1, kb) do { const LAS char* Ks_ = K_lds + (kb) * SHM_K; \
        _Pragma("unroll") for (int d0 = 0; d0 < 4; ++d0) { const int cb = (d0 * 16 + hi * 8) * 2; \
            const bf16x8 b0 = *(const LAS bf16x8*)(Ks_ + KSWZ64(r32, cb)), b1 = *(const LAS bf16x8*)(Ks_ + KSWZ64(32 + r32, cb)); \
            if (d0 == 0 && !ALIBI) { const f32x16 z = f32x16{}; P0 = MFMA32(b0, qr[0], z); P1 = MFMA32(b1, qr[0], z); } else { P0 = MFMA32(b0, qr[d0], P0); P1 = MFMA32(b1, qr[d0], P1); } } } while (0)
#define PARTIAL(P0, P1, FIRST, SUB, ALPHA, RESCF) do { const float rm_ = rowmax(P0, P1) - (ALIBI ? 0.f : mhat); ALPHA = 1.f; RESCF = false; float dl_ = 0.f; \
        if ((FIRST) || __any(rm_ > THR)) { dl_ = (FIRST) ? rm_ : __builtin_fmaxf(rm_, 0.f); mhat += dl_; if (!(FIRST)) { ALPHA = __builtin_amdgcn_exp2f(-dl_); RESCF = true; } } \
        SUB = ALIBI ? dl_ : mhat; \
        _Pragma("unroll") for (int r = 0; r < 16; ++r) P0[r] = __builtin_amdgcn_exp2f(P0[r] - SUB); } while (0)
#define FINISH(P0, P1, SUB, ALPHA) do { _Pragma("unroll") for (int r = 0; r < 16; ++r) P1[r] = __builtin_amdgcn_exp2f(P1[r] - SUB); \
        float ps_ = 0.f; _Pragma("unroll") for (int r = 0; r < 16; ++r) ps_ += P0[r]; _Pragma("unroll") for (int r = 0; r < 16; ++r) ps_ += P1[r]; \
        l_reg = l_reg * (ALPHA) + ps_; \
        { const v4u w0 = {cvtpk(P0[0], P0[1]), cvtpk(P0[2], P0[3]), cvtpk(P0[4], P0[5]), cvtpk(P0[6], P0[7])}, w1 = {cvtpk(P0[8], P0[9]), cvtpk(P0[10], P0[11]), cvtpk(P0[12], P0[13]), cvtpk(P0[14], P0[15])}; \
          const v4u w2 = {cvtpk(P1[0], P1[1]), cvtpk(P1[2], P1[3]), cvtpk(P1[4], P1[5]), cvtpk(P1[6], P1[7])}, w3 = {cvtpk(P1[8], P1[9]), cvtpk(P1[10], P1[11]), cvtpk(P1[12], P1[13]), cvtpk(P1[14], P1[15])}; \
          pa0 = __builtin_bit_cast(bf16x8, w0); pa1 = __builtin_bit_cast(bf16x8, w1); pa2 = __builtin_bit_cast(bf16x8, w2); pa3 = __builtin_bit_cast(bf16x8, w3); } } while (0)
#define PVX(voff) do { const unsigned vb_ = vb0 + (unsigned)(voff); pv_one<NCB, 0>(o[0], vb_, pa0, pa1, pa2, pa3); pv_one<NCB, 1>(o[1], vb_, pa0, pa1, pa2, pa3); \
        if constexpr (NCB == 4) { pv_one<NCB, 2>(o[2], vb_, pa0, pa1, pa2, pa3); pv_one<NCB, 3>(o[3], vb_, pa0, pa1, pa2, pa3); } } while (0)
#define RESC(ALPHA, RESCF) do { if (RESCF) { if (hi == 0) al_l[r32] = (ALPHA); asm volatile("s_waitcnt lgkmcnt(0)" ::: "memory"); \
        _Pragma("unroll") for (int r = 0; r < 16; ++r) { const float f_ = al_l[crow(r, hi)]; _Pragma("unroll") for (int d = 0; d < NCB; ++d) o[d][r] *= f_; } } } while (0)
#define ROT() do { const int t_ = vprev; vprev = vcur; vcur = vnext; vnext = t_; } while (0)
    f32x16 pA0 = f32x16{}, pA1 = f32x16{}, pB0 = f32x16{}, pB1 = f32x16{}; float subA, subB, alA, alB; bool rsA, rsB; bf16x8 pa0, pa1, pa2, pa3;
    int vprev = 0, vcur = SHM_V, vnext = 2 * SHM_V;
    SLOAD(TILE(0)); asm volatile("s_waitcnt vmcnt(0)" ::: "memory"); SWRITE(0, 0); SLOAD(TILE(1)); __syncthreads();
    SWRITE(1, SHM_V); SLOAD(TILE(2));
    INITC(pA0, pA1, TILE(0)); QKT(pA0, pA1, 0); PARTIAL(pA0, pA1, true, subA, alA, rsA);
    __syncthreads();
    for (int j = 1; j < NT; j += 2) {
        if (j + 1 < NT) { SWRITE(0, vnext); if (j + 2 < NT) SLOAD(TILE(j + 2)); }
        SBAR(); INITC(pB0, pB1, TILE(j)); QKT(pB0, pB1, 1);
        FINISH(pA0, pA1, subA, alA); SBAR();
        PVX(vprev); PARTIAL(pB0, pB1, false, subB, alB, rsB); RESC(alB, rsB);
        __syncthreads(); ROT();
        if (j + 1 >= NT) break;
        if (j + 2 < NT) { SWRITE(1, vnext); if (j + 3 < NT) SLOAD(TILE(j + 3)); }
        SBAR(); INITC(pA0, pA1, TILE(j + 1)); QKT(pA0, pA1, 0);
        FINISH(pB0, pB1, subB, alB); SBAR();
        PVX(vprev); PARTIAL(pA0, pA1, false, subA, alA, rsA); RESC(alA, rsA);
        __syncthreads(); ROT();
    }
    FINISH(pB0, pB1, subB, alB); SBAR();
    PVX(vprev);
    { auto rr = __builtin_amdgcn_permlane32_swap(__float_as_uint(l_reg), __float_as_uint(l_reg), false, false); l_out = __uint_as_float(rr[0]) + __uint_as_float(rr[1]); }
    __syncthreads();
#undef TILE
#undef SLOAD
#undef SWRITE
#undef INITC
#undef QKT
#undef PARTIAL
#undef FINISH
#undef PVX
#undef RESC
#undef ROT
}

template <int NCB> __device__ __forceinline__ void stage_o(const f32x16 (&o)[NCB], float l, LAS float* stg, LAS float* li_l, int r32, int hi) {
#pragma unroll
    for (int d = 0; d < NCB; ++d)
#pragma unroll
        for (int r = 0; r < 16; ++r) stg[crow(r, hi) * (NCB * 32) + d * 32 + r32] = o[d][r];
    if (hi == 0) li_l[r32] = l;
    asm volatile("s_waitcnt lgkmcnt(0)" ::: "memory");
}
__device__ __forceinline__ v4u pack8(f32x4 a, f32x4 b) { v4u w = {cvtpk(a[0], a[1]), cvtpk(a[2], a[3]), cvtpk(b[0], b[1]), cvtpk(b[2], b[3])}; return w; }
__device__ __forceinline__ void unpack8(v4u g, f32x4& a, f32x4& b) {
    a = (f32x4){__uint_as_float(g.x << 16), __uint_as_float(g.x & 0xffff0000u), __uint_as_float(g.y << 16), __uint_as_float(g.y & 0xffff0000u)};
    b = (f32x4){__uint_as_float(g.z << 16), __uint_as_float(g.z & 0xffff0000u), __uint_as_float(g.w << 16), __uint_as_float(g.w & 0xffff0000u)}; }

__device__ __forceinline__ void unit_A(int b, int h, int qb, const bf16_t* QA, const bf16_t* KA, const bf16_t* VA, const bf16_t* GA, bf16_t* Y, const float* subw, const float* lq1, const float* lk1, const float* lq2, const float* lk2,
                                       float* scr, LAS char* lds) {
    const float cal = __builtin_ldexpf(1.f, -2 * (h + 1)) * LOG2E;
#pragma nounroll
    for (int mp = 0; mp < 2; ++mp) {
        f32x16 o[4]; float l;
        { const int wid = __builtin_amdgcn_readfirstlane(threadIdx.x >> 6); const size_t row0 = (size_t)b * SEQ + qb * 256 + wid * 32;
          ATT_BODY_A<128, true, 512, 512, 512>(QA + row0 * 512 + h * 128 + mp * 64, KA + (size_t)b * SEQ * 512 + h * 128 + mp * 64, VA + (size_t)b * SEQ * 512 + h * 128,
                                              qb * 256 + wid * 32, qb * 4, cal, o, l, lds); }
        int tid2 = threadIdx.x; asm volatile("" : "+v"(tid2));
        const int lane = tid2 & 63, wid = __builtin_amdgcn_readfirstlane(tid2 >> 6), rsub = lane >> 4, c8 = (lane & 15) * 8;
        LAS float* stg = (LAS float*)(lds + wid * 16384); LAS float* li_l = (LAS float*)(lds + LDS_WS) + wid * 64;
        float* scrw = scr + wid * 4096; const size_t row0 = (size_t)b * SEQ + qb * 256 + wid * 32;
        stage_o<4>(o, l, stg, li_l, lane & 31, lane >> 5);
        if (mp == 0) {
#pragma unroll 2
            for (int it = 0; it < 8; ++it) { const int row = it * 4 + rsub; const float rl = __builtin_amdgcn_rcpf(li_l[row]);
                const f32x4 v0 = *(const LAS f32x4*)(stg + row * 128 + c8) * rl, v1 = *(const LAS f32x4*)(stg + row * 128 + c8 + 4) * rl;
                *(f32x4*)(scrw + row * 128 + c8) = v0; *(f32x4*)(scrw + row * 128 + c8 + 4) = v1; }
        } else {
            const f32x4 w0 = *(const f32x4*)(subw + c8), w1 = *(const f32x4*)(subw + c8 + 4);
            const float lam = expf(wave_sum(lq1[lane] * lk1[lane])) - expf(wave_sum(lq2[lane] * lk2[lane])) + LAM_INIT;
#pragma unroll 2
            for (int it = 0; it < 8; ++it) { const int row = it * 4 + rsub; const float rl = __builtin_amdgcn_rcpf(li_l[row]);
                const f32x4 v0 = *(const LAS f32x4*)(stg + row * 128 + c8) * rl, v1 = *(const LAS f32x4*)(stg + row * 128 + c8 + 4) * rl;
                const f32x4 d0 = *(const f32x4*)(scrw + row * 128 + c8) - lam * v0, d1 = *(const f32x4*)(scrw + row * 128 + c8 + 4) - lam * v1;
                float ss = (d0[0] * d0[0] + d0[1] * d0[1]) + (d0[2] * d0[2] + d0[3] * d0[3]) + (d1[0] * d1[0] + d1[1] * d1[1]) + (d1[2] * d1[2] + d1[3] * d1[3]);
                ss += __shfl_xor(ss, 1); ss += __shfl_xor(ss, 2); ss += __shfl_xor(ss, 4); ss += __shfl_xor(ss, 8);
                const float rs = __builtin_amdgcn_rsqf(ss * (1.f / 128.f) + NORM_EPS) * (1.f - LAM_INIT);
                f32x4 g0, g1; unpack8(*(const v4u*)(GA + (row0 + row) * 512 + h * 128 + c8), g0, g1);
                *(v4u*)(Y + (row0 + row) * 1024 + h * 128 + c8) = pack8(d0 * rs * w0 * g0, d1 * rs * w1 * g1); }
        }
        __syncthreads();
    }
}
__device__ __forceinline__ void unit_B(int b, int head, int qb, const bf16_t* QB, const bf16_t* KB, const bf16_t* VB, const bf16_t* GB, bf16_t* Y, LAS char* lds) {
    f32x16 o[2]; float l;
    { const int wid = __builtin_amdgcn_readfirstlane(threadIdx.x >> 6); const size_t row0 = (size_t)b * SEQ + qb * 256 + wid * 32; const int kvh = head >> 2;
      ATT_BODY_B<64, false, 512, 128, 128>(QB + row0 * 512 + head * 64, KB + (size_t)b * SEQ * 128 + kvh * 64, VB + (size_t)b * SEQ * 128 + kvh * 64, qb * 256 + wid * 32, 0, 0.f, o, l, lds); }
    int tid2 = threadIdx.x; asm volatile("" : "+v"(tid2));
    const int lane = tid2 & 63, wid = __builtin_amdgcn_readfirstlane(tid2 >> 6), rsub = lane >> 3, c8 = (lane & 7) * 8;
    LAS float* stg = (LAS float*)(lds + wid * 16384); LAS float* li_l = (LAS float*)(lds + LDS_WS) + wid * 64; const size_t row0 = (size_t)b * SEQ + qb * 256 + wid * 32;
    stage_o<2>(o, l, stg, li_l, lane & 31, lane >> 5);
#pragma unroll 2
    for (int it = 0; it < 4; ++it) { const int row = it * 8 + rsub; const float rl = __builtin_amdgcn_rcpf(li_l[row]);
        const f32x4 v0 = *(const LAS f32x4*)(stg + row * 64 + c8) * rl, v1 = *(const LAS f32x4*)(stg + row * 64 + c8 + 4) * rl;
        f32x4 g0, g1; unpack8(*(const v4u*)(GB + (row0 + row) * 512 + head * 64 + c8), g0, g1);
        *(v4u*)(Y + (row0 + row) * 1024 + 512 + head * 64 + c8) = pack8(v0 * g0, v1 * g1); }
    __syncthreads();
}
#undef SBAR
}

#define XB_TMO      128
#define XB_XCNT(j)  (256  + 64 * (j))
#define XB_XSUB(j)  (1280 + 64 * (j))
#define XB_XGEN(j)  (2304 + 64 * (j))
#define XB_TOP      3328
#define XB_TOPGEN   3392
#define XCD_BAR_WORDS 3456
#define XB_SPIN_CAP (1u << 18)

__device__ __forceinline__ unsigned xb_ld(unsigned* p)              { return __hip_atomic_load(p, __ATOMIC_RELAXED, __HIP_MEMORY_SCOPE_AGENT); }
__device__ __forceinline__ unsigned xb_add(unsigned* p, unsigned v) { return __hip_atomic_fetch_add(p, v, __ATOMIC_RELAXED, __HIP_MEMORY_SCOPE_AGENT); }
__device__ __forceinline__ unsigned xb_xcc_id() { return (unsigned)__builtin_amdgcn_s_getreg((3 << 11) | 20) & 0xFu; }
#define XB_SPIN(cond, bar) do { unsigned _sp = 0; while (cond) { __builtin_amdgcn_s_sleep(1); \
    if ((++_sp & 255u) == 0u) { if (xb_ld(&(bar)[XB_TMO])) break; if (_sp > XB_SPIN_CAP) { atomicAdd(&(bar)[XB_TMO], 1u); break; } } } } while (0)

struct XcdBarrier {
    unsigned* bar; unsigned x;
    volatile LAS unsigned* st;
};

__device__ __forceinline__ XcdBarrier xcd_barrier_post(unsigned* bar, volatile LAS unsigned* st) {
    XcdBarrier b; b.bar = bar; b.x = xb_xcc_id(); b.st = st;
    if (threadIdx.x == 0) (void)xb_add(&bar[XB_XCNT(b.x)], 1u);
    return b;
}
__device__ __forceinline__ void xcd_barrier_complete(unsigned* bar, unsigned x, unsigned& nloc, unsigned& nx) {
    const unsigned G = gridDim.x * gridDim.y * gridDim.z;
    unsigned sum, cnt, mine, sp = 0u;
    for (;;) {
        sum = 0u; cnt = 0u; mine = 0u;
#pragma unroll
        for (unsigned j = 0; j < 16; ++j) { const unsigned c = xb_ld(&bar[XB_XCNT(j)]); sum += c; cnt += (c > 0u) ? 1u : 0u; mine = (j == x) ? c : mine; }
        if (sum == G) break;
        __builtin_amdgcn_s_sleep(1);
        if ((++sp & 255u) == 0u) { if (xb_ld(&bar[XB_TMO])) break; if (sp > XB_SPIN_CAP) { atomicAdd(&bar[XB_TMO], 1u); break; } }
    }
    nloc = mine > 0u ? mine : 1u; nx = cnt > 0u ? cnt : 1u;
}

__device__ __forceinline__ void xcd_barrier(const XcdBarrier& b) {
    asm volatile("s_waitcnt vmcnt(0)" ::: "memory");
    __syncthreads();
    if (threadIdx.x == 0) {
        unsigned* bar = b.bar;
        __builtin_amdgcn_s_waitcnt(0);
        unsigned nloc = b.st[0], nx = b.st[1];
        if (nloc == 0u) { xcd_barrier_complete(bar, b.x, nloc, nx); b.st[0] = nloc; b.st[1] = nx; }
        const unsigned old = xb_add(&bar[XB_XSUB(b.x)], 1u);
        const unsigned gen = old / nloc;
        if (old + 1u == (gen + 1u) * nloc) {
            __builtin_amdgcn_fence(__ATOMIC_RELEASE, "agent");
            asm volatile("s_waitcnt vmcnt(0)" ::: "memory");
            const unsigned og = xb_add(&bar[XB_TOP], 1u);
            const unsigned tg = og / nx;
            if (og + 1u == (tg + 1u) * nx) xb_add(&bar[XB_TOPGEN], 1u);
            else XB_SPIN(xb_ld(&bar[XB_TOPGEN]) == tg, bar);
            __builtin_amdgcn_fence(__ATOMIC_ACQUIRE, "agent");
            xb_add(&bar[XB_XGEN(b.x)], 1u);
            asm volatile("s_waitcnt vmcnt(0)" ::: "memory");
        } else {
            XB_SPIN(xb_ld(&bar[XB_XGEN(b.x)]) == gen, bar);
            __builtin_amdgcn_fence(__ATOMIC_ACQUIRE, "agent");
            asm volatile("s_waitcnt vmcnt(0)" ::: "memory");
        }
    }
    __syncthreads();
}

constexpr size_t MiB = 1u << 20;
constexpr size_t WS_CTL = 0, CTL_ZERO_BYTES = 64 * 1024;
constexpr size_t WS_MODP = 1 * MiB;
constexpr size_t WS_MODF = 2 * MiB;
constexpr size_t WS_TAB = 2 * MiB + 64 * 1024;
constexpr size_t WS_WIN = 4 * MiB, WS_WOUT = 12 * MiB;
constexpr size_t WS_H = 16 * MiB;
constexpr size_t WS_QA = 48 * MiB, WS_KA = 64 * MiB, WS_VA = 80 * MiB, WS_GA = 96 * MiB;
constexpr size_t WS_QB = 112 * MiB, WS_KB = 128 * MiB, WS_VB = 132 * MiB, WS_GB = 136 * MiB;
constexpr size_t WS_QBR = 152 * MiB, WS_KBR = 184 * MiB;
constexpr size_t WS_O0 = 192 * MiB;
constexpr size_t WS_END = 224 * MiB;

constexpr int NWAVES = 8, LDS_BYTES = 147456;
constexpr int LDS_CTL = 147456 - 256;
constexpr int CW_BAR = 4096;
constexpr int LDS_MISC = 131072;

struct Args { const float *x, *c, *w_ada, *b_ada, *norm_w, *w_in, *lq1, *lk1, *lq2, *lk2, *subln_w, *qn_w, *kn_w, *w_out, *fn_w; float* out; unsigned char* ws; int ph_lo, ph_hi; };

__device__ __forceinline__ void transpose_item(const float* W, int K, int N, bf16_t* WT, LAS float* scr, int item, int lane) {
    const int nblk = N / 32, kb = item / nblk, nb = item % nblk, k0 = 64 * kb, n0 = 32 * nb;
#pragma unroll 8
    for (int i = 0; i < 32; ++i) { const int kk = 2 * i + (lane >> 5); scr[kk * 33 + (lane & 31)] = W[(size_t)(k0 + kk) * N + n0 + (lane & 31)]; }
    asm volatile("s_waitcnt lgkmcnt(0)" ::: "memory");
    const int c = lane & 7;
#pragma unroll
    for (int j = 0; j < 4; ++j) { const int n = (lane >> 3) + 8 * j; const LAS float* s = scr + (8 * c) * 33 + n;
        v4u o; o.x = cvtpk(s[0 * 33], s[1 * 33]); o.y = cvtpk(s[2 * 33], s[3 * 33]); o.z = cvtpk(s[4 * 33], s[5 * 33]); o.w = cvtpk(s[6 * 33], s[7 * 33]);
        *(v4u*)(WT + (size_t)(n0 + n) * K + k0 + 8 * c) = o; }
    asm volatile("s_waitcnt lgkmcnt(0)" ::: "memory");
}

__global__ void __launch_bounds__(NWAVES * 64, 2) mega(Args a) {
    extern __shared__ __attribute__((aligned(16))) unsigned char lds_raw[];
    LAS unsigned char* lds = (LAS unsigned char*)lds_raw;
    const int tid = threadIdx.x, lane = tid & 63; const int wid = __builtin_amdgcn_readfirstlane(tid >> 6);
    const int G = gridDim.x, bx = blockIdx.x, vcu = (G % 8 == 0) ? (bx % 8) * (G / 8) + bx / 8 : bx;
    const int gw = vcu * NWAVES + wid, NGW = G * NWAVES;
    unsigned char* ws = a.ws;
#define WS_PTRS() unsigned char* wsp = a.ws; asm volatile("" : "+s"(wsp)); \
    float* modp = (float*)(wsp + WS_MODP); float* modf = (float*)(wsp + WS_MODF); f32x2* tab = (f32x2*)(wsp + WS_TAB); \
    bf16_t* WIN = (bf16_t*)(wsp + WS_WIN); bf16_t* WOUT = (bf16_t*)(wsp + WS_WOUT); bf16_t* H = (bf16_t*)(wsp + WS_H); bf16_t* Y = H; \
    bf16_t *QA = (bf16_t*)(wsp + WS_QA), *KA = (bf16_t*)(wsp + WS_KA), *VA = (bf16_t*)(wsp + WS_VA), *GA = (bf16_t*)(wsp + WS_GA); \
    bf16_t *QB = (bf16_t*)(wsp + WS_QB), *KB = (bf16_t*)(wsp + WS_KB), *VB = (bf16_t*)(wsp + WS_VB), *GB = (bf16_t*)(wsp + WS_GB); \
    float *QBR = (float*)(wsp + WS_QBR), *KBR = (float*)(wsp + WS_KBR); \
    (void)modp; (void)modf; (void)tab; (void)WIN; (void)WOUT; (void)H; (void)Y; (void)QA; (void)KA; (void)VA; (void)GA; (void)QB; (void)KB; (void)VB; (void)GB; (void)QBR; (void)KBR
    const int lo = a.ph_lo, hi_ = a.ph_hi;
    volatile LAS unsigned* MISC = (volatile LAS unsigned*)(lds + LDS_CTL);
    if (tid < 2) MISC[tid] = 0u;
    __syncthreads();
    XcdBarrier bar = xcd_barrier_post((unsigned*)(ws + WS_CTL) + CW_BAR, MISC);
#ifndef PH_MASK
#define PH_MASK 0x7f
#endif
#define IN(k) (((PH_MASK >> (k)) & 1) && lo <= (k) && (k) < hi_)
#define SEAM(k) do { if (IN(k) && IN((k) + 1)) xcd_barrier(bar); } while (0)

    if (IN(0)) { WS_PTRS();
        for (int it = gw; it < 384; it += NGW) {
            const int s = it / 12, col = (it % 12) * 256 + lane * 4;
            f32x4 a0 = {0.f, 0.f, 0.f, 0.f}, a1 = a0;
#pragma unroll 8
            for (int k = s * 32; k < s * 32 + 32; ++k) { const f32x4 w = *(const f32x4*)(a.w_ada + (size_t)k * 3072 + col);
                const float c0 = a.c[k], c1 = a.c[1024 + k]; a0 += pg8::silu_f(c0) * w; a1 += pg8::silu_f(c1) * w; }
            *(f32x4*)(modp + (size_t)(s * 2 + 0) * 3072 + col) = a0; *(f32x4*)(modp + (size_t)(s * 2 + 1) * 3072 + col) = a1;
        }
        { const int g = vcu * 512 + tid;
          if (g < 3072) { const int p = g >> 4, i = g & 15; const float freq = 1.0f / powf(10000.0f, (float)i * 2.0f / 32.0f);
              const float ang = (float)(p < 128 ? p : p - 128) * freq; float sn, cs; sincosf(ang, &sn, &cs); tab[g] = (f32x2){cs, sn}; } }
        LAS float* scr = (LAS float*)(lds + wid * 16384);
        constexpr int I_IN = (DM / 64) * (NPROJ / 32), I_OUT = (DM / 64) * (DM / 32);
        for (int it = gw; it < I_IN + I_OUT; it += NGW) {
            if (it < I_IN) transpose_item(a.w_in, DM, NPROJ, WIN, scr, it, lane); else transpose_item(a.w_out, DM, DM, WOUT, scr, it - I_IN, lane);
        }
    }
    SEAM(0);
    if (IN(1)) { WS_PTRS();
        LAS float* gsh = (LAS float*)(lds + LDS_MISC);
        for (int chunk = bx; chunk < 256; chunk += G) {
            const int b = chunk >> 7;
            for (int j = tid; j < 2048; j += 512) { const int col = j & 1023, midx = (j < 1024) ? 1024 + col : col;
                float v = a.b_ada[midx];
#pragma unroll 8
                for (int s = 0; s < 32; ++s) v += modp[(size_t)(s * 2 + b) * 3072 + midx];
                gsh[j] = (j < 1024) ? a.norm_w[col] * (1.f + v) : v; }
            if (chunk < 12) { const int j = chunk * 512 + tid, bb = j / 3072, idx = j % 3072; float v = a.b_ada[idx];
#pragma unroll 8
                for (int s = 0; s < 32; ++s) v += modp[(size_t)(s * 2 + bb) * 3072 + idx];
                modf[j] = v; }
            __syncthreads();
            for (int i = 0; i < 8; ++i) { const size_t row = (size_t)chunk * 64 + wid * 8 + i;
                const f32x4* xr = (const f32x4*)(a.x + row * DM) + lane; f32x4 v[4]; float s = 0.f;
#pragma unroll
                for (int j = 0; j < 4; ++j) { v[j] = xr[64 * j]; s += (v[j].x * v[j].x + v[j].y * v[j].y) + (v[j].z * v[j].z + v[j].w * v[j].w); }
                const float rstd = __builtin_amdgcn_rsqf(wave_sum(s) * (1.f / DM) + NORM_EPS);
                unsigned long long* o8 = (unsigned long long*)(H + row * DM) + lane;
#pragma unroll
                for (int j = 0; j < 4; ++j) { const int c0 = 4 * lane + 256 * j; const f32x4 g = *(const LAS f32x4*)(gsh + c0), sh = *(const LAS f32x4*)(gsh + 1024 + c0);
                    const f32x4 hv = v[j] * rstd * g + sh; o8[64 * j] = (unsigned long long)cvtpk(hv.x, hv.y) | ((unsigned long long)cvtpk(hv.z, hv.w) << 32); } }
            __syncthreads();
        }
    }
    SEAM(1);
    if (IN(2)) { WS_PTRS();
        pg8::Gemm g{H, WIN, M, NPROJ, DM}; pg8::StaticOrder S; S.init(M, NPROJ, G, bx);
        pg8::EpiProj E{QA, KA, VA, GA, VB, GB, QBR, KBR, C2};
#ifdef DUP_P2
        for (int rep_ = 0; rep_ < 2; ++rep_)
#endif
        pg8::gemm_phase<pg8::EpiProj, pg8::StaticOrder, true, true>(lds, g, S, E);
    }
    SEAM(2);
    if (IN(3)) { WS_PTRS();
        for (int it = gw; it < M * 10; it += NGW) { const int row = it / 10, hh = it % 10;
            const float raw = hh < 8 ? QBR[(size_t)row * 512 + hh * 64 + lane] : KBR[(size_t)row * 128 + (hh - 8) * 64 + lane];
            const float rstd = __builtin_amdgcn_rsqf(wave_sum(raw * raw) * (1.f / 64.f) + NORM_EPS);
            const float y = raw * rstd * (hh < 8 ? a.qn_w[lane] : a.kn_w[lane]);
            const int t = row & (SEQ - 1), pos = lane < 32 ? (t >> 6) : 128 + (t & 63);
            const f32x2 cs = tab[pos * 16 + (lane & 15)]; const float pr = __shfl_xor(y, 16);
            const float ov = (lane & 16) ? y * cs.x + pr * cs.y : y * cs.x - pr * cs.y;
            if (hh < 8) QB[(size_t)row * 512 + hh * 64 + lane] = f2bf(ov * C2); else KB[(size_t)row * 128 + (hh - 8) * 64 + lane] = f2bf(ov); }
    }
    SEAM(3);
    if (IN(4)) { WS_PTRS();
        float* scr = (float*)(wsp + WS_O0) + (size_t)bx * 32768;
        for (int u = vcu; u < 256; u += G) {
#ifndef NO_A
#ifdef DUP_A
            for (int rep_ = 0; rep_ < 2; ++rep_)
#endif
            att::unit_A(u >> 7, (u >> 5) & 3, u & 31, QA, KA, VA, GA, Y, a.subln_w, a.lq1, a.lk1, a.lq2, a.lk2, scr, (LAS char*)lds);
#endif
#ifndef NO_B
#ifdef DUP_B
            for (int rep_ = 0; rep_ < 2; ++rep_)
#endif
#pragma nounroll
            for (int i = 0; i < 2; ++i) { const int ub = u * 2 + i; att::unit_B(ub >> 8, (ub >> 5) & 7, ub & 31, QB, KB, VB, GB, Y, (LAS char*)lds); }
#endif
        }
    }
    SEAM(4);
    if (IN(5)) { WS_PTRS();
        pg8::Gemm g{Y, WOUT, M, DM, DM}; pg8::StaticOrder S; S.init(M, DM, G, bx);
        pg8::EpiOut E{a.x, a.out, modf};
        pg8::gemm_phase<pg8::EpiOut, pg8::StaticOrder, true, true>(lds, g, S, E);
    }
    SEAM(5);
    if (IN(6)) { WS_PTRS();
        for (int row = gw; row < M; row += NGW) {
            f32x4* xr = (f32x4*)(a.out + (size_t)row * DM) + lane; f32x4 v[4]; float s = 0.f;
#pragma unroll
            for (int j = 0; j < 4; ++j) { v[j] = xr[64 * j]; s += (v[j].x * v[j].x + v[j].y * v[j].y) + (v[j].z * v[j].z + v[j].w * v[j].w); }
            const float rstd = __builtin_amdgcn_rsqf(wave_sum(s) * (1.f / DM) + NORM_EPS);
#pragma unroll
            for (int j = 0; j < 4; ++j) { const f32x4 w = *((const f32x4*)a.fn_w + lane + 64 * j); xr[64 * j] = v[j] * rstd * w; }
        }
    }
#undef IN
#undef SEAM
}

extern "C" void kernel_launch(void* const* d_in, const int* in_sizes, int n_in, void* d_out, int out_size, void* d_ws, size_t ws_size, hipStream_t stream) {
    static int grid = 0;
    if (grid == 0) {
        if (n_in != 15 || in_sizes[0] != M * DM || out_size != M * DM || ws_size < WS_END) { fprintf(stderr, "kernel_launch: unexpected shapes (n_in %d, in0 %d, out %d, ws %zu)\n", n_in, n_in > 0 ? in_sizes[0] : -1, out_size, ws_size); grid = -1; return; }
        int dev = 0, cus = 0, per_cu = 0;
        hipGetDevice(&dev); hipDeviceGetAttribute(&cus, hipDeviceAttributeMultiprocessorCount, dev);
        if (hipFuncSetAttribute((const void*)mega, hipFuncAttributeMaxDynamicSharedMemorySize, LDS_BYTES) != hipSuccess) { fprintf(stderr, "kernel_launch: hipFuncSetAttribute failed\n"); grid = -1; return; }
        if (hipOccupancyMaxActiveBlocksPerMultiprocessor(&per_cu, (const void*)mega, NWAVES * 64, LDS_BYTES) != hipSuccess || per_cu < 1) { fprintf(stderr, "kernel_launch: occupancy query failed (%d)\n", per_cu); (void)hipGetLastError(); per_cu = 1; }
        grid = cus * per_cu; if (grid > 256) grid = 256;
    }
    if (grid < 0) return;
    Args a{};
    a.x = (const float*)d_in[0]; a.c = (const float*)d_in[1]; a.w_ada = (const float*)d_in[2]; a.b_ada = (const float*)d_in[3]; a.norm_w = (const float*)d_in[4]; a.w_in = (const float*)d_in[5];
    a.lq1 = (const float*)d_in[6]; a.lk1 = (const float*)d_in[7]; a.lq2 = (const float*)d_in[8]; a.lk2 = (const float*)d_in[9]; a.subln_w = (const float*)d_in[10];
    a.qn_w = (const float*)d_in[11]; a.kn_w = (const float*)d_in[12]; a.w_out = (const float*)d_in[13]; a.fn_w = (const float*)d_in[14];
    a.out = (float*)d_out; a.ws = (unsigned char*)d_ws; a.ph_lo = 0; a.ph_hi = 7;
    if (hipMemsetAsync((char*)d_ws + WS_CTL, 0, CTL_ZERO_BYTES, stream) != hipSuccess) { fprintf(stderr, "kernel_launch: hipMemsetAsync failed\n"); return; }
    hipLaunchKernelGGL(mega, dim3(grid), dim3(NWAVES * 64), LDS_BYTES, stream, a);
    const hipError_t e = hipPeekAtLastError();
    if (e != hipSuccess) fprintf(stderr, "kernel_launch: launch failed: %s (grid %d)\n", hipGetErrorName(e), grid);
}
```

```cpp
#include <hip/hip_runtime.h>
#include <cstdio>
#include <cstdint>

namespace pg8 {
#define PG8_LAS __attribute__((address_space(3)))
typedef unsigned short bf16_t;
typedef short bf16x8 __attribute__((ext_vector_type(8)));
typedef float f32x4 __attribute__((ext_vector_type(4)));
typedef unsigned u32x4 __attribute__((ext_vector_type(4)));
constexpr int BM = 256, BK = 64, HALF = 128, HTB = HALF * BK * 2  , STAGE_BYTES = 8 * HTB, NXCD = 8, WGM = 8;

__host__ __device__ __forceinline__ int lds_byte(int r, int c) { const int st = (r >> 4) * 2 + (c >> 5), rr = r & 15, cc = c & 31, ob = rr * 64 + cc * 2; return st * 1024 + (ob ^ (((ob >> 9) & 1) << 5)); }
__host__ __device__ __forceinline__ void stage_rc(int b, int& R, int& C) { const int st = b / 1024, sb = b % 1024, swz = sb ^ (((sb >> 9) & 1) << 5); R = (st >> 1) * 16 + swz / 64; C = (st & 1) * 32 + (swz % 64) / 2; }
__host__ __device__ __forceinline__ int perm32(int rho) { const int n = rho >> 4, i = rho & 15; return 8 * (i >> 2) + 4 * n + (i & 3); }

struct Unit { int pm, pn; };
struct Gemm { const bf16_t* A; const bf16_t* Bt; int M, N, K; };

struct StaticOrder {
    int nM, nN, nwg, G, c;
    __host__ __device__ void init(int M, int N, int G_, int c_) { nM = M / BM; nN = N / BM; nwg = nM * nN; G = G_; c = c_; }
    __host__ __device__ bool next(int i, Unit& u) const {
        const long L = (long)i * G + c; if (L >= nwg) return false;
        int wgid = (int)L; { const int q = nwg / NXCD, r = nwg % NXCD, xcd = wgid % NXCD, off = wgid / NXCD; wgid = (xcd < r ? xcd * (q + 1) : r * (q + 1) + (xcd - r) * q) + off; }
        const int nig = WGM * nN, gid = wgid / nig, fm = gid * WGM, gsz = (nM - fm) < WGM ? (nM - fm) : WGM;
        u.pm = fm + ((wgid % nig) % gsz); u.pn = (wgid % nig) / gsz; return true;
    }
    __device__ __forceinline__ void a_ready(const Unit&) const {}
    __device__ __forceinline__ void done(const Unit&) const {}
};

__device__ __forceinline__ unsigned cvt_pk_bf16(float lo, float hi) { unsigned r; asm volatile("v_cvt_pk_bf16_f32 %0, %1, %2" : "=v"(r) : "v"(lo), "v"(hi)); return r; }
typedef float f32x2 __attribute__((ext_vector_type(2)));

__device__ __forceinline__ float silu_f(float v) { return v * __builtin_amdgcn_rcpf(1.f + __builtin_amdgcn_exp2f(-1.4426950408889634f * v)); }
struct EpiProj {
    static constexpr bool PERM = true, AFTER_DRAIN = false;
    bf16_t *QA, *KA, *VA, *GA, *VB, *GB; float *QBR, *KBR; float qscale;
    __device__ __forceinline__ void operator()(const f32x4 (&acc)[2][2][4][2], const Unit& u, int wr, int wc, int fr, int fq) const {
        const int row0 = u.pm * BM + wr * 64 + fr, cin = wc * 32 + 8 * fq;
#pragma unroll
        for (int bj = 0; bj < 2; ++bj) {
            const int blk = u.pn * 2 + bj;
            int mode = 0, ld = 512, c0 = 0; bf16_t* d16 = nullptr; float* d32 = nullptr;
            if (blk < 4)       { mode = 1; d16 = QA; c0 = blk * 128 + cin; }
            else if (blk < 8)  { mode = 0; d16 = KA; c0 = (blk - 4) * 128 + cin; }
            else if (blk < 12) { mode = 0; d16 = VA; c0 = (blk - 8) * 128 + cin; }
            else if (blk < 16) { mode = 2; d16 = GA; c0 = (blk - 12) * 128 + cin; }
            else if (blk < 20) { mode = 3; d32 = QBR; c0 = (blk - 16) * 128 + cin; }
            else if (blk == 20) { mode = 3; d32 = KBR; ld = 128; c0 = cin; }
            else if (blk == 21) { mode = 0; d16 = VB; ld = 128; c0 = cin; }
            else               { mode = 2; d16 = GB; c0 = (blk - 22) * 128 + cin; }
#pragma unroll
            for (int ai = 0; ai < 2; ++ai)
#pragma unroll
                for (int m = 0; m < 4; ++m) {
                    const size_t off = (size_t)(row0 + ai * HALF + m * 16) * ld + c0;
                    f32x4 v0 = acc[ai][bj][m][0], v1 = acc[ai][bj][m][1];
                    if (mode == 3) { *(f32x4*)(d32 + off) = v0; *(f32x4*)(d32 + off + 4) = v1; }
                    else {
                        if (mode == 1) { v0 = v0 * qscale; v1 = v1 * qscale; }
                        if (mode == 2) { v0 = (f32x4){silu_f(v0[0]), silu_f(v0[1]), silu_f(v0[2]), silu_f(v0[3])}; v1 = (f32x4){silu_f(v1[0]), silu_f(v1[1]), silu_f(v1[2]), silu_f(v1[3])}; }
                        u32x4 w; w.x = cvt_pk_bf16(v0[0], v0[1]); w.y = cvt_pk_bf16(v0[2], v0[3]); w.z = cvt_pk_bf16(v1[0], v1[1]); w.w = cvt_pk_bf16(v1[2], v1[3]);
                        *(u32x4*)(d16 + off) = w;
                    }
                }
        }
    }
};
struct EpiOut {
    static constexpr bool PERM = true, AFTER_DRAIN = false;
    const float* x; float* out; const float* modf;
    __device__ __forceinline__ void operator()(const f32x4 (&acc)[2][2][4][2], const Unit& u, int wr, int wc, int fr, int fq) const {
        const int row0 = u.pm * BM + wr * 64 + fr, b = u.pm >> 5;
#pragma unroll
        for (int bj = 0; bj < 2; ++bj) {
            const int col0 = u.pn * BM + bj * HALF + wc * 32 + 8 * fq;
            const f32x4 g0 = *(const f32x4*)(modf + b * 3072 + 2048 + col0), g1 = *(const f32x4*)(modf + b * 3072 + 2048 + col0 + 4);
#pragma unroll
            for (int ai = 0; ai < 2; ++ai)
#pragma unroll
                for (int m = 0; m < 4; ++m) {
                    const size_t off = (size_t)(row0 + ai * HALF + m * 16) * 1024 + col0;
                    const f32x4 x0 = *(const f32x4*)(x + off), x1 = *(const f32x4*)(x + off + 4);
                    *(f32x4*)(out + off) = x0 + g0 * acc[ai][bj][m][0]; *(f32x4*)(out + off + 4) = x1 + g1 * acc[ai][bj][m][1];
                }
        }
    }
};

template <class Epi, class Sched, bool ALIGN_EPI = false, bool SP2 = false>
__device__ __forceinline__ void gemm_phase(PG8_LAS unsigned char* lds, const Gemm g, const Sched& S, const Epi& E) {
    const int tid = threadIdx.x, wid = __builtin_amdgcn_readfirstlane(tid >> 6), lane = tid & 63, wr = wid >> 2, wc = wid & 3, fr = lane & 15, fq = lane >> 4;
    const int K = g.K, nt = K / BK;
    unsigned voffA[2], voffB[2];
#pragma unroll
    for (int i = 0; i < 2; ++i) { int R, C; stage_rc(tid * 16 + i * 8192, R, C); const int Rb = Epi::PERM ? ((R & ~31) + perm32(R & 31)) : R;
        voffA[i] = (unsigned)(R * K + C) * 2u; voffB[i] = (unsigned)(Rb * K + C) * 2u; }
    const size_t kstep = (size_t)(BK * 2);
    const size_t hstep = (size_t)HALF * K * 2;
    const size_t tstep = 2 * hstep;
    const unsigned ldsw = (unsigned)wid * 1024u;
    const int aoff = lds_byte(wr * 64 + fr, fq * 8), boff = lds_byte(wc * 32 + fr, fq * 8);
#define PG8_SA(b, h) (((b) * 2 + (h)) * HTB)
#define PG8_SB(b, h) ((4 + (b) * 2 + (h)) * HTB)
#define PG8_STAGE(bufoff, gbase, voff) do { _Pragma("unroll") for (int _i = 0; _i < 2; ++_i) \
        __builtin_amdgcn_global_load_lds((const unsigned*)((const char*)(gbase) + (voff)[_i]), (PG8_LAS unsigned*)(lds + (bufoff) + ldsw + _i * 8192), 16, 0, 0); } while (0)
#define PG8_LDA(dst, b, h) do { _Pragma("unroll") for (int m = 0; m < 4; ++m) _Pragma("unroll") for (int k = 0; k < 2; ++k) dst[m][k] = *(const PG8_LAS bf16x8*)(lds + PG8_SA(b, h) + aoff + m * 2048 + k * 1024); } while (0)
#define PG8_LDB(dst, b, h) do { _Pragma("unroll") for (int n = 0; n < 2; ++n) _Pragma("unroll") for (int k = 0; k < 2; ++k) dst[n][k] = *(const PG8_LAS bf16x8*)(lds + PG8_SB(b, h) + boff + n * 2048 + k * 1024); } while (0)
#define PG8_MMA(ai, bj, At, Bt) do { __builtin_amdgcn_s_setprio(1); _Pragma("unroll") for (int m = 0; m < 4; ++m) _Pragma("unroll") for (int n = 0; n < 2; ++n) _Pragma("unroll") for (int k = 0; k < 2; ++k) \
        acc[ai][bj][m][n] = __builtin_amdgcn_mfma_f32_16x16x32_bf16(Bt[n][k], At[m][k], acc[ai][bj][m][n], 0, 0, 0); __builtin_amdgcn_s_setprio(0); } while (0)
#define PG8_WAIT_V(n) asm volatile("s_waitcnt vmcnt(" #n ")" ::: "memory")
#define PG8_WAIT_L(n) asm volatile("s_waitcnt lgkmcnt(" #n ")" ::: "memory")
#define PG8_BAR __builtin_amdgcn_s_barrier()
#define PG8_SCHED __builtin_amdgcn_sched_barrier(0)
    Unit cur, nxt; int ui = 0;
    if (!S.next(0, cur)) return;
    f32x4 acc[2][2][4][2];
#pragma unroll
    for (int a = 0; a < 2; ++a)
#pragma unroll
        for (int b = 0; b < 2; ++b)
#pragma unroll
            for (int m = 0; m < 4; ++m)
#pragma unroll
                for (int n = 0; n < 2; ++n) acc[a][b][m][n] = (f32x4){0.f, 0.f, 0.f, 0.f};
    bf16x8 At[4][2], B0[2][2], B1[2][2];
    const char* cA = (const char*)g.A + (size_t)cur.pm * tstep; const char* cB = (const char*)g.Bt + (size_t)cur.pn * tstep;
    S.a_ready(cur);
    if constexpr (SP2) {
        PG8_STAGE(PG8_SB(0, 0), cB, voffB); PG8_STAGE(PG8_SB(0, 1), cB + hstep, voffB); PG8_STAGE(PG8_SA(0, 0), cA, voffA); PG8_STAGE(PG8_SA(0, 1), cA + hstep, voffA);
        if (wr == 1) PG8_BAR;
        PG8_WAIT_V(2); PG8_BAR;
        PG8_STAGE(PG8_SB(1, 0), cB + kstep, voffB); PG8_STAGE(PG8_SA(1, 0), cA + kstep, voffA); PG8_STAGE(PG8_SB(1, 1), cB + hstep + kstep, voffB);
        PG8_WAIT_V(6); PG8_BAR;
    } else {
        PG8_STAGE(PG8_SB(0, 0), cB, voffB); PG8_STAGE(PG8_SA(0, 0), cA, voffA); PG8_STAGE(PG8_SB(0, 1), cB + hstep, voffB); PG8_STAGE(PG8_SA(0, 1), cA + hstep, voffA);
        if (wr == 1) PG8_BAR;
        PG8_WAIT_V(4); PG8_BAR;
        PG8_STAGE(PG8_SB(1, 0), cB + kstep, voffB); PG8_STAGE(PG8_SA(1, 0), cA + kstep, voffA); PG8_STAGE(PG8_SB(1, 1), cB + hstep + kstep, voffB);
        PG8_WAIT_V(6); PG8_BAR;
    }
    for (;;) {
        const bool has_next = S.next(ui + 1, nxt);
        const char* nA = has_next ? (const char*)g.A + (size_t)nxt.pm * tstep : cA; const char* nB = has_next ? (const char*)g.Bt + (size_t)nxt.pn * tstep : cB;
        for (int t = 0; t < nt; t += 2) {
            const bool last = (t == nt - 2);
            const char* a1 = cA + (size_t)(t + 1) * kstep;
            const char* a2 = last ? nA : cA + (size_t)(t + 2) * kstep; const char* b2 = last ? nB : cB + (size_t)(t + 2) * kstep;
            const char* a3 = a2 + kstep; const char* b3 = b2 + kstep;
            if (last && has_next) S.a_ready(nxt);
            if constexpr (SP2) {
            PG8_LDB(B0, 0, 0); PG8_LDB(B1, 0, 1); PG8_SCHED; PG8_LDA(At, 0, 0); PG8_STAGE(PG8_SA(1, 1), a1 + hstep, voffA);
            PG8_WAIT_V(8); PG8_WAIT_L(0); PG8_BAR; PG8_MMA(0, 0, At, B0); PG8_MMA(0, 1, At, B1); PG8_BAR; PG8_SCHED;
            PG8_LDA(At, 0, 1); PG8_STAGE(PG8_SB(0, 0), b2, voffB); PG8_STAGE(PG8_SB(0, 1), b2 + hstep, voffB); PG8_STAGE(PG8_SA(0, 0), a2, voffA);
            PG8_WAIT_V(8); PG8_WAIT_L(0); PG8_BAR; PG8_MMA(1, 0, At, B0); PG8_MMA(1, 1, At, B1); PG8_BAR; PG8_SCHED;
            PG8_LDB(B0, 1, 0); PG8_LDB(B1, 1, 1); PG8_SCHED; PG8_LDA(At, 1, 0); PG8_STAGE(PG8_SA(0, 1), a2 + hstep, voffA);
            PG8_WAIT_V(8); PG8_WAIT_L(0); PG8_BAR; PG8_MMA(0, 0, At, B0); PG8_MMA(0, 1, At, B1); PG8_BAR; PG8_SCHED;
            PG8_LDA(At, 1, 1); PG8_STAGE(PG8_SB(1, 0), b3, voffB); PG8_STAGE(PG8_SB(1, 1), b3 + hstep, voffB); PG8_STAGE(PG8_SA(1, 0), a3, voffA);
            PG8_WAIT_V(8); PG8_WAIT_L(0); PG8_BAR; PG8_MMA(1, 0, At, B0); PG8_MMA(1, 1, At, B1); PG8_BAR; PG8_SCHED;
            } else {
            PG8_LDB(B0, 0, 0); PG8_SCHED; PG8_LDA(At, 0, 0); PG8_STAGE(PG8_SA(1, 1), a1 + hstep, voffA);
            PG8_WAIT_L(8); PG8_BAR; PG8_WAIT_L(0); PG8_MMA(0, 0, At, B0); PG8_BAR; PG8_SCHED;
            PG8_LDB(B1, 0, 1); PG8_STAGE(PG8_SB(0, 0), b2, voffB);
            PG8_BAR; PG8_WAIT_L(0); PG8_MMA(0, 1, At, B1); PG8_BAR;
            PG8_LDA(At, 0, 1); PG8_STAGE(PG8_SA(0, 0), a2, voffA);
            PG8_BAR; PG8_WAIT_L(0); PG8_MMA(1, 0, At, B0); PG8_BAR; PG8_SCHED;
            PG8_STAGE(PG8_SB(0, 1), b2 + hstep, voffB);
            PG8_WAIT_V(6); PG8_BAR; PG8_MMA(1, 1, At, B1); PG8_BAR;
            PG8_LDB(B0, 1, 0); PG8_SCHED; PG8_LDA(At, 1, 0); PG8_STAGE(PG8_SA(0, 1), a2 + hstep, voffA);
            PG8_WAIT_L(8); PG8_BAR; PG8_WAIT_L(0); PG8_MMA(0, 0, At, B0); PG8_BAR; PG8_SCHED;
            PG8_LDB(B1, 1, 1); PG8_STAGE(PG8_SB(1, 0), b3, voffB);
            PG8_BAR; PG8_WAIT_L(0); PG8_MMA(0, 1, At, B1); PG8_BAR;
            PG8_LDA(At, 1, 1); PG8_STAGE(PG8_SA(1, 0), a3, voffA);
            PG8_BAR; PG8_WAIT_L(0); PG8_MMA(1, 0, At, B0); PG8_BAR; PG8_SCHED;
            PG8_STAGE(PG8_SB(1, 1), b3 + hstep, voffB);
            PG8_WAIT_V(6); PG8_BAR; PG8_MMA(1, 1, At, B1); PG8_BAR;
            }
        }
        if constexpr (ALIGN_EPI) { if (wr == 0) PG8_BAR; }
        if constexpr (!Epi::AFTER_DRAIN) { E(acc, cur, wr, wc, fr, fq); S.done(cur); }
        if (!has_next) break;
#pragma unroll
        for (int a = 0; a < 2; ++a)
#pragma unroll
            for (int b = 0; b < 2; ++b)
#pragma unroll
                for (int m = 0; m < 4; ++m)
#pragma unroll
                    for (int n = 0; n < 2; ++n) acc[a][b][m][n] = (f32x4){0.f, 0.f, 0.f, 0.f};
        cur = nxt; cA = nA; cB = nB; ++ui;
        if constexpr (ALIGN_EPI) { if (wr == 1) PG8_BAR; }
    }
    PG8_WAIT_V(0);
    if constexpr (!ALIGN_EPI) { if (wr == 0) PG8_BAR; }
    PG8_BAR;
    if constexpr (Epi::AFTER_DRAIN) { E.fused(acc, cur, wr, wc, fr, fq, lds, wid, lane); S.done(cur); }
#undef PG8_SA
#undef PG8_SB
#undef PG8_STAGE
#undef PG8_LDA
#undef PG8_LDB
#undef PG8_MMA
#undef PG8_WAIT_V
#undef PG8_WAIT_L
#undef PG8_BAR
#undef PG8_SCHED
}
}

#define LAS __attribute__((address_space(3)))
typedef unsigned short bf16_t;
typedef float f32x4 __attribute__((ext_vector_type(4)));
typedef float f32x2 __attribute__((ext_vector_type(2)));
typedef unsigned v4u __attribute__((ext_vector_type(4)));

constexpr int BATCH = 2, SEQ = 8192, DM = 1024, M = BATCH * SEQ, NPROJ = 3328;
constexpr float NORM_EPS = 1e-6f, LOG2E = 1.4426950408889634f;
constexpr float C2 = 0.125f * LOG2E;
constexpr float LAM_INIT = 0.2f;

__device__ __forceinline__ unsigned cvtpk(float lo, float hi) { typedef __bf16 b2 __attribute__((ext_vector_type(2))); f32x2 v = {lo, hi}; b2 b = __builtin_convertvector(v, b2); return __builtin_bit_cast(unsigned, b); }
__device__ __forceinline__ bf16_t f2bf(float f) { return (bf16_t)(cvtpk(f, 0.f) & 0xffffu); }
__device__ __forceinline__ float bf2f(bf16_t v) { return __uint_as_float((unsigned)v << 16); }
__device__ __forceinline__ float wave_sum(float v) {
#pragma unroll
    for (int o = 1; o < 64; o <<= 1) v += __shfl_xor(v, o);
    return v;
}

#ifndef ATT_BODY_A
#define ATT_BODY_A attn_body
#endif
#ifndef ATT_BODY_B
#define ATT_BODY_B attn_body_p
#endif
namespace att {
typedef short bf16x8 __attribute__((ext_vector_type(8)));
typedef short s16x4 __attribute__((ext_vector_type(4)));
typedef float f32x16 __attribute__((ext_vector_type(16)));
constexpr int NW = 8, QBLK = 32, KVBLK = 64, NT = SEQ / KVBLK;
constexpr float THR = 8.f;
constexpr int SHM_V = 16384, SHM_K = 8192, LDS_V = 0, LDS_K = 2 * SHM_V, LDS_WS = 131072 + 8192;
#define SBAR() __builtin_amdgcn_sched_barrier(0)
#define KSWZ64(row, colB) ((row) * 128 + ((colB) ^ ((((row) >> 1) & 7) << 4)))
#define MFMA32(a, b, c) __builtin_amdgcn_mfma_f32_32x32x16_bf16(a, b, c, 0, 0, 0)
#define MX3(a, b, c) __builtin_fmaxf(__builtin_fmaxf((a), (b)), (c))
__device__ __forceinline__ int crow(int r, int hi) { return (r & 3) + 8 * (r >> 2) + 4 * hi; }
template <int NCB> __device__ __forceinline__ int v_st(int k, int c) { return ((k >> 3) * NCB + (c >> 5)) * 512 + ((k & 7) * 32 + (c & 31)) * 2; }
__device__ __forceinline__ int v_rd_base(int lane) { return ((lane & 3) << 3) | (((lane >> 2) & 3) << 6) | (((lane >> 4) & 1) << 5) | (((lane >> 5) & 1) << 8); }
template <int OFF> __device__ __forceinline__ s16x4 tr_read(unsigned vb) { s16x4 r; asm volatile("ds_read_b64_tr_b16 %0, %1 offset:%2" : "=&v"(r) : "v"(vb), "i"(OFF) : "memory"); return r; }
template <int NCB, int D0> __device__ __forceinline__ void pv_one(f32x16& od, unsigned vb, bf16x8 pa0, bf16x8 pa1, bf16x8 pa2, bf16x8 pa3) {
#define VOFF(ks, half) (D0 * 512 + (2 * (ks) + (half)) * NCB * 512)
    const s16x4 l0 = tr_read<VOFF(0, 0)>(vb), h0 = tr_read<VOFF(0, 1)>(vb), l1 = tr_read<VOFF(1, 0)>(vb), h1 = tr_read<VOFF(1, 1)>(vb);
    const s16x4 l2 = tr_read<VOFF(2, 0)>(vb), h2 = tr_read<VOFF(2, 1)>(vb), l3 = tr_read<VOFF(3, 0)>(vb), h3 = tr_read<VOFF(3, 1)>(vb);
#undef VOFF
    asm volatile("s_waitcnt lgkmcnt(0)" ::: "memory"); SBAR();
#define PK(L, H) (bf16x8){L[0], L[1], L[2], L[3], H[0], H[1], H[2], H[3]}
    od = MFMA32(pa0, PK(l0, h0), od); od = MFMA32(pa1, PK(l1, h1), od); od = MFMA32(pa2, PK(l2, h2), od); od = MFMA32(pa3, PK(l3, h3), od);
#undef PK
}
__device__ __forceinline__ float rowmax(const f32x16& p0, const f32x16& p1) {
    float a = MX3(p0[0], p0[1], p1[0]), b = MX3(p0[2], p0[3], p1[1]); a = MX3(a, p1[2], p1[3]);
#pragma unroll
    for (int r = 4; r < 16; r += 4) { a = MX3(a, p0[r], p0[r + 1]); b = MX3(b, p0[r + 2], p0[r + 3]); a = MX3(a, p1[r], p1[r + 1]); b = MX3(b, p1[r + 2], p1[r + 3]); }
    float rm = __builtin_fmaxf(a, b);
    auto rr = __builtin_amdgcn_permlane32_swap(__float_as_uint(rm), __float_as_uint(rm), false, false);
    return __builtin_fmaxf(__uint_as_float(rr[0]), __uint_as_float(rr[1]));
}

template <int DV, bool ALIBI, int LDQ, int LDK, int LDV>
__device__ __forceinline__ void attn_body(const bf16_t* __restrict__ Qw, const bf16_t* __restrict__ Kh, const bf16_t* __restrict__ Vh, int qw0, int t0, float cal,
                                          f32x16 (&o)[DV / 32], float& l_out, LAS char* lds) {
    constexpr int NCB = DV / 32;
    int tid = threadIdx.x; asm volatile("" : "+v"(tid));
    const int lane = tid & 63, r32 = lane & 31, hi = lane >> 5; const int wid = __builtin_amdgcn_readfirstlane(tid >> 6);
    LAS char* V_lds = lds + LDS_V; LAS char* K_lds = lds + LDS_K;
    LAS float* al_l = (LAS float*)(lds + LDS_WS) + wid * 64 + 32;
    float mhat = 0.f, l_reg = 0.f;
#pragma unroll
    for (int d = 0; d < NCB; ++d) o[d] = f32x16{};
    bf16x8 qr[4];
#pragma unroll
    for (int d0 = 0; d0 < 4; ++d0) qr[d0] = *(const bf16x8*)(Qw + (size_t)r32 * LDQ + d0 * 16 + hi * 8);
    const int kr = tid >> 3, kc = (tid & 7) * 8, kst = KSWZ64(kr, kc * 2);
    const int vr = (DV == 64) ? (tid >> 3) : (tid >> 4), vc = (DV == 64) ? (tid & 7) * 8 : (tid & 15) * 8;
    const int vst0 = v_st<NCB>(vr, vc), vst1 = v_st<NCB>(32 + vr, vc);
    const unsigned vb0 = (unsigned)(uintptr_t)V_lds + (unsigned)v_rd_base(lane);
    const bf16_t* kg = Kh + (size_t)kr * LDK + kc; const bf16_t* vg = Vh + (size_t)vr * LDV + vc;
    bf16x8 sk, sv0, sv1;
#define TILE(i) (((i) + t0) & (NT - 1))
#define SLOAD(tl) do { const size_t k0_ = (size_t)(tl) * KVBLK; sk = *(const bf16x8*)(kg + k0_ * LDK); sv0 = *(const bf16x8*)(vg + k0_ * LDV); \
        if (DV == 128) sv1 = *(const bf16x8*)(vg + (k0_ + 32) * LDV); } while (0)
#define SWRITE(b) do { *(LAS bf16x8*)(K_lds + (b) * SHM_K + kst) = sk; *(LAS bf16x8*)(V_lds + (b) * SHM_V + vst0) = sv0; \
        if (DV == 128) *(LAS bf16x8*)(V_lds + (b) * SHM_V + vst1) = sv1; } while (0)
    float ncal = -cal; asm volatile("" : "+v"(ncal));
    const int qpos = qw0 + r32; const float c32 = 32.f * cal;
#define COMPUTE(b, tl, FIRST) do { f32x16 p0, p1; \
        if (ALIBI) { const float cdq = cal * (float)(qpos - 4 * hi - (tl) * KVBLK), nm = -mhat, e1_ = cdq - c32; \
            _Pragma("unroll") for (int r = 0; r < 16; ++r) { const float kf_ = (float)((r & 3) + 8 * (r >> 2)); \
                p0[r] = nm - __builtin_fabsf(__builtin_fmaf(ncal, kf_, cdq)); p1[r] = nm - __builtin_fabsf(__builtin_fmaf(ncal, kf_, e1_)); } } \
        { const LAS char* Ks_ = K_lds + (b) * SHM_K; \
          _Pragma("unroll") for (int d0 = 0; d0 < 4; ++d0) { const int cb = (d0 * 16 + hi * 8) * 2; \
            const bf16x8 b0 = *(const LAS bf16x8*)(Ks_ + KSWZ64(r32, cb)), b1 = *(const LAS bf16x8*)(Ks_ + KSWZ64(32 + r32, cb)); \
            if (d0 == 0 && !ALIBI) { const f32x16 z = f32x16{}; p0 = MFMA32(b0, qr[0], z); p1 = MFMA32(b1, qr[0], z); } else { p0 = MFMA32(b0, qr[d0], p0); p1 = MFMA32(b1, qr[d0], p1); } } } \
        const float rm_ = rowmax(p0, p1) - (ALIBI ? 0.f : mhat); float alpha_ = 1.f; bool resc_ = false; \
        if ((FIRST) || __any(rm_ > THR)) { const float dl_ = (FIRST) ? rm_ : __builtin_fmaxf(rm_, 0.f); mhat += dl_; \
            if (!(FIRST)) { alpha_ = __builtin_amdgcn_exp2f(-dl_); resc_ = true; } } \
        SUBEXP(p0, p1); \
        float ps_ = 0.f; _Pragma("unroll") for (int r = 0; r < 16; ++r) ps_ += p0[r]; _Pragma("unroll") for (int r = 0; r < 16; ++r) ps_ += p1[r]; \
        l_reg = l_reg * alpha_ + ps_; \
        const v4u w0 = {cvtpk(p0[0], p0[1]), cvtpk(p0[2], p0[3]), cvtpk(p0[4], p0[5]), cvtpk(p0[6], p0[7])}, w1 = {cvtpk(p0[8], p0[9]), cvtpk(p0[10], p0[11]), cvtpk(p0[12], p0[13]), cvtpk(p0[14], p0[15])}; \
        const v4u w2 = {cvtpk(p1[0], p1[1]), cvtpk(p1[2], p1[3]), cvtpk(p1[4], p1[5]), cvtpk(p1[6], p1[7])}, w3 = {cvtpk(p1[8], p1[9]), cvtpk(p1[10], p1[11]), cvtpk(p1[12], p1[13]), cvtpk(p1[14], p1[15])}; \
        const bf16x8 pa0 = __builtin_bit_cast(bf16x8, w0), pa1 = __builtin_bit_cast(bf16x8, w1), pa2 = __builtin_bit_cast(bf16x8, w2), pa3 = __builtin_bit_cast(bf16x8, w3); \
        if (resc_) { if (hi == 0) al_l[r32] = alpha_; asm volatile("s_waitcnt lgkmcnt(0)" ::: "memory"); \
            _Pragma("unroll") for (int r = 0; r < 16; ++r) { const float f_ = al_l[crow(r, hi)]; _Pragma("unroll") for (int d = 0; d < NCB; ++d) o[d][r] *= f_; } } \
        const unsigned vb_ = vb0 + (b) * SHM_V; pv_one<NCB, 0>(o[0], vb_, pa0, pa1, pa2, pa3); pv_one<NCB, 1>(o[1], vb_, pa0, pa1, pa2, pa3); \
        if constexpr (NCB == 4) { pv_one<NCB, 2>(o[2], vb_, pa0, pa1, pa2, pa3); pv_one<NCB, 3>(o[3], vb_, pa0, pa1, pa2, pa3); } } while (0)
#define SUBEXP(P0, P1) do { const float s_ = ALIBI ? (mhat - mh_old_) : mhat; \
        _Pragma("unroll") for (int r = 0; r < 16; ++r) { P0[r] = __builtin_amdgcn_exp2f(P0[r] - s_); P1[r] = __builtin_amdgcn_exp2f(P1[r] - s_); } } while (0)
    float mh_old_ = 0.f;
    SLOAD(TILE(0)); asm volatile("s_waitcnt vmcnt(0)" ::: "memory"); SWRITE(0); SLOAD(TILE(1)); __syncthreads();
    for (int i = 0; i < NT; i += 2) {
        SWRITE(1); if (i + 2 < NT) SLOAD(TILE(i + 2));
        mh_old_ = mhat;
        COMPUTE(0, TILE(i), (i == 0));
        __syncthreads();
        if (i + 2 < NT) { SWRITE(0); if (i + 3 < NT) SLOAD(TILE(i + 3)); }
        mh_old_ = mhat;
        COMPUTE(1, TILE(i + 1), false);
        __syncthreads();
    }
    { auto rr = __builtin_amdgcn_permlane32_swap(__float_as_uint(l_reg), __float_as_uint(l_reg), false, false); l_out = __uint_as_float(rr[0]) + __uint_as_float(rr[1]); }
#undef TILE
#undef SLOAD
#undef SWRITE
#undef COMPUTE
#undef SUBEXP
}

template <int DV, bool ALIBI, int LDQ, int LDK, int LDV>
__device__ __forceinline__ void attn_body_p(const bf16_t* __restrict__ Qw, const bf16_t* __restrict__ Kh, const bf16_t* __restrict__ Vh, int qw0, int t0, float cal,
                                            f32x16 (&o)[DV / 32], float& l_out, LAS char* lds) {
    constexpr int NCB = DV / 32, PLDS_K = 3 * SHM_V;
    int tid = threadIdx.x; asm volatile("" : "+v"(tid));
    const int lane = tid & 63, r32 = lane & 31, hi = lane >> 5; const int wid = __builtin_amdgcn_readfirstlane(tid >> 6);
    LAS char* V_lds = lds; LAS char* K_lds = lds + PLDS_K;
    LAS float* al_l = (LAS float*)(lds + LDS_WS) + wid * 64 + 32;
    float mhat = 0.f, l_reg = 0.f;
#pragma unroll
    for (int d = 0; d < NCB; ++d) o[d] = f32x16{};
    bf16x8 qr[4];
#pragma unroll
    for (int d0 = 0; d0 < 4; ++d0) qr[d0] = *(const bf16x8*)(Qw + (size_t)r32 * LDQ + d0 * 16 + hi * 8);
    const int kr = tid >> 3, kc = (tid & 7) * 8, kst = KSWZ64(kr, kc * 2);
    const int vr = (DV == 64) ? (tid >> 3) : (tid >> 4), vc = (DV == 64) ? (tid & 7) * 8 : (tid & 15) * 8;
    const int vst0 = v_st<NCB>(vr, vc), vst1 = v_st<NCB>(32 + vr, vc);
    const unsigned vb0 = (unsigned)(uintptr_t)V_lds + (unsigned)v_rd_base(lane);
    const bf16_t* kg = Kh + (size_t)kr * LDK + kc; const bf16_t* vg = Vh + (size_t)vr * LDV + vc;
    bf16x8 sk, sv0, sv1;
#define TILE(i) (((i) + t0) & (NT - 1))
#define SLOAD(tl) do { const size_t k0_ = (size_t)(tl) * KVBLK; sk = *(const bf16x8*)(kg + k0_ * LDK); sv0 = *(const bf16x8*)(vg + k0_ * LDV); \
        if (DV == 128) sv1 = *(const bf16x8*)(vg + (k0_ + 32) * LDV); } while (0)
#define SWRITE(kb, voff) do { *(LAS bf16x8*)(K_lds + (kb) * SHM_K + kst) = sk; *(LAS bf16x8*)(V_lds + (voff) + vst0) = sv0; \
        if (DV == 128) *(LAS bf16x8*)(V_lds + (voff) + vst1) = sv1; } while (0)
    float ncal = -cal; asm volatile("" : "+v"(ncal));
    const int qpos = qw0 + r32; const float c32 = 32.f * cal;
#define INITC(P0, P1, tl) do { if (ALIBI) { const float cdq = cal * (float)(qpos - 4 * hi - (tl) * KVBLK), nm = -mhat, e1_ = cdq - c32; \
        _Pragma("unroll") for (int r = 0; r < 16; ++r) { const float kf_ = (float)((r & 3) + 8 * (r >> 2)); \
            P0[r] = nm - __builtin_fabsf(__builtin_fmaf(ncal, kf_, cdq)); P1[r] = nm - __builtin_fabsf(__builtin_fmaf(ncal, kf_, e1_)); } } } while (0)
#define QKT(P0, P1, kb) do { const LAS char* Ks_ = K_lds + (kb) * SHM_K; \
        _Pragma("unroll") for (int d0 = 0; d0 < 4; ++d0) { const int cb = (d0 * 16 + hi * 8) * 2; \
            const bf16x8 b0 = *(const LAS bf16x8*)(Ks_ + KSWZ64(r32, cb)), b1 = *(const LAS bf16x8*)(Ks_ + KSWZ64(32 + r32, cb)); \
            if (d0 == 0 && !ALIBI) { const f32x16 z = f32x16{}; P0 = MFMA32(b0, qr[0], z); P1 = MFMA32(b1, qr[0], z); } else { P0 = MFMA32(b0, qr[d0], P0); P1 = MFMA32(b1, qr[d0], P1); } } } while (0)
#define PARTIAL(P0, P1, FIRST, SUB, ALPHA, RESCF) do { const float rm_ = rowmax(P0, P1) - (ALIBI ? 0.f : mhat); ALPHA = 1.f; RESCF = false; float dl_ = 0.f; \
        if ((FIRST) || __any(rm_ > THR)) { dl_ = (FIRST) ? rm_ : __builtin_fmaxf(rm_, 0.f); mhat += dl_; if (!(FIRST)) { ALPHA = __builtin_amdgcn_exp2f(-dl_); RESCF = true; } } \
        SUB = ALIBI ? dl_ : mhat; \
        _Pragma("unroll") for (int r = 0; r < 16; ++r) P0[r] = __builtin_amdgcn_exp2f(P0[r] - SUB); } while (0)
#define FINISH(P0, P1, SUB, ALPHA) do { _Pragma("unroll") for (int r = 0; r < 16; ++r) P1[r] = __builtin_amdgcn_exp2f(P1[r] - SUB); \
        float ps_ = 0.f; _Pragma("unroll") for (int r = 0; r < 16; ++r) ps_ += P0[r]; _Pragma("unroll") for (int r = 0; r < 16; ++r) ps_ += P1[r]; \
        l_reg = l_reg * (ALPHA) + ps_; \
        { const v4u w0 = {cvtpk(P0[0], P0[1]), cvtpk(P0[2], P0[3]), cvtpk(P0[4], P0[5]), cvtpk(P0[6], P0[7])}, w1 = {cvtpk(P0[8], P0[9]), cvtpk(P0[10], P0[11]), cvtpk(P0[12], P0[13]), cvtpk(P0[14], P0[15])}; \
          const v4u w2 = {cvtpk(P1[0], P1[1]), cvtpk(P1[2], P1[3]), cvtpk(P1[4], P1[5]), cvtpk(P1[6], P1[7])}, w3 = {cvtpk(P1[8], P1[9]), cvtpk(P1[10], P1[11]), cvtpk(P1[12], P1[13]), cvtpk(P1[14], P1[15])}; \
          pa0 = __builtin_bit_cast(bf16x8, w0); pa1 = __builtin_bit_cast(bf16x8, w1); pa2 = __builtin_bit_cast(bf16x8, w2); pa3 = __builtin_bit_cast(bf16x8, w3); } } while (0)
#define PVX(voff) do { const unsigned vb_ = vb0 + (unsigned)(voff); pv_one<NCB, 0>(o[0], vb_, pa0, pa1, pa2, pa3); pv_one<NCB, 1>(o[1], vb_, pa0, pa1, pa2, pa3); \
        if constexpr (NCB == 4) { pv_one<NCB, 2>(o[2], vb_, pa0, pa1, pa2, pa3); pv_one<NCB, 3>(o[3], vb_, pa0, pa1, pa2, pa3); } } while (0)
#define RESC(ALPHA, RESCF) do { if (RESCF) { if (hi == 0) al_l[r32] = (ALPHA); asm volatile("s_waitcnt lgkmcnt(0)" ::: "memory"); \
        _Pragma("unroll") for (int r = 0; r < 16; ++r) { const float f_ = al_l[crow(r, hi)]; _Pragma("unroll") for (int d = 0; d < NCB; ++d) o[d][r] *= f_; } } } while (0)
#define ROT() do { const int t_ = vprev; vprev = vcur; vcur = vnext; vnext = t_; } while (0)
    f32x16 pA0 = f32x16{}, pA1 = f32x16{}, pB0 = f32x16{}, pB1 = f32x16{}; float subA, subB, alA, alB; bool rsA, rsB; bf16x8 pa0, pa1, pa2, pa3;
    int vprev = 0, vcur = SHM_V, vnext = 2 * SHM_V;
    SLOAD(TILE(0)); asm volatile("s_waitcnt vmcnt(0)" ::: "memory"); SWRITE(0, 0); SLOAD(TILE(1)); __syncthreads();
    SWRITE(1, SHM_V); SLOAD(TILE(2));
    INITC(pA0, pA1, TILE(0)); QKT(pA0, pA1, 0); PARTIAL(pA0, pA1, true, subA, alA, rsA);
    __syncthreads();
    for (int j = 1; j < NT; j += 2) {
        if (j + 1 < NT) { SWRITE(0, vnext); if (j + 2 < NT) SLOAD(TILE(j + 2)); }
        SBAR(); INITC(pB0, pB1, TILE(j)); QKT(pB0, pB1, 1);
        FINISH(pA0, pA1, subA, alA); SBAR();
        PVX(vprev); PARTIAL(pB0, pB1, false, subB, alB, rsB); RESC(alB, rsB);
        __syncthreads(); ROT();
        if (j + 1 >= NT) break;
        if (j + 2 < NT) { SWRITE(1, vnext); if (j + 3 < NT) SLOAD(TILE(j + 3)); }
        SBAR(); INITC(pA0, pA1, TILE(j + 1)); QKT(pA0, pA1, 0);
        FINISH(pB0, pB1, subB, alB); SBAR();
        PVX(vprev); PARTIAL(pA0, pA1, false, subA, alA, rsA); RESC(alA, rsA);
        __syncthreads(); ROT();
    }
    FINISH(pB0, pB1, subB, alB); SBAR();
    PVX(vprev);
    { auto rr = __builtin_amdgcn_permlane32_swap(__float_as_uint(l_reg), __float_as_uint(l_reg), false, false); l_out = __uint_as_float(rr[0]) + __uint_as_float(rr[1]); }
    __syncthreads();
#undef TILE
#undef SLOAD
#undef SWRITE
#undef INITC
#undef QKT
#undef PARTIAL
#undef FINISH
#undef PVX
#undef RESC
#undef ROT
}

template <int NCB> __device__ __forceinline__ void stage_o(const f32x16 (&o)[NCB], float l, LAS float* stg, LAS float* li_l, int r32, int hi) {
#pragma unroll
    for (int d = 0; d < NCB; ++d)
#pragma unroll
        for (int r = 0; r < 16; ++r) stg[crow(r, hi) * (NCB * 32) + d * 32 + r32] = o[d][r];
    if (hi == 0) li_l[r32] = l;
    asm volatile("s_waitcnt lgkmcnt(0)" ::: "memory");
}
__device__ __forceinline__ v4u pack8(f32x4 a, f32x4 b) { v4u w = {cvtpk(a[0], a[1]), cvtpk(a[2], a[3]), cvtpk(b[0], b[1]), cvtpk(b[2], b[3])}; return w; }
__device__ __forceinline__ void unpack8(v4u g, f32x4& a, f32x4& b) {
    a = (f32x4){__uint_as_float(g.x << 16), __uint_as_float(g.x & 0xffff0000u), __uint_as_float(g.y << 16), __uint_as_float(g.y & 0xffff0000u)};
    b = (f32x4){__uint_as_float(g.z << 16), __uint_as_float(g.z & 0xffff0000u), __uint_as_float(g.w << 16), __uint_as_float(g.w & 0xffff0000u)}; }

__device__ __forceinline__ void unit_A(int b, int h, int qb, const bf16_t* QA, const bf16_t* KA, const bf16_t* VA, const bf16_t* GA, bf16_t* Y, const float* subw, const float* lq1, const float* lk1, const float* lq2, const float* lk2,
                                       float* scr, LAS char* lds) {
    const float cal = __builtin_ldexpf(1.f, -2 * (h + 1)) * LOG2E;
#pragma nounroll
    for (int mp = 0; mp < 2; ++mp) {
        f32x16 o[4]; float l;
        { const int wid = __builtin_amdgcn_readfirstlane(threadIdx.x >> 6); const size_t row0 = (size_t)b * SEQ + qb * 256 + wid * 32;
          ATT_BODY_A<128, true, 512, 512, 512>(QA + row0 * 512 + h * 128 + mp * 64, KA + (size_t)b * SEQ * 512 + h * 128 + mp * 64, VA + (size_t)b * SEQ * 512 + h * 128,
                                              qb * 256 + wid * 32, qb * 4, cal, o, l, lds); }
        int tid2 = threadIdx.x; asm volatile("" : "+v"(tid2));
        const int lane = tid2 & 63, wid = __builtin_amdgcn_readfirstlane(tid2 >> 6), rsub = lane >> 4, c8 = (lane & 15) * 8;
        LAS float* stg = (LAS float*)(lds + wid * 16384); LAS float* li_l = (LAS float*)(lds + LDS_WS) + wid * 64;
        float* scrw = scr + wid * 4096; const size_t row0 = (size_t)b * SEQ + qb * 256 + wid * 32;
        stage_o<4>(o, l, stg, li_l, lane & 31, lane >> 5);
        if (mp == 0) {
#pragma unroll 2
            for (int it = 0; it < 8; ++it) { const int row = it * 4 + rsub; const float rl = __builtin_amdgcn_rcpf(li_l[row]);
                const f32x4 v0 = *(const LAS f32x4*)(stg + row * 128 + c8) * rl, v1 = *(const LAS f32x4*)(stg + row * 128 + c8 + 4) * rl;
                *(f32x4*)(scrw + row * 128 + c8) = v0; *(f32x4*)(scrw + row * 128 + c8 + 4) = v1; }
        } else {
            const f32x4 w0 = *(const f32x4*)(subw + c8), w1 = *(const f32x4*)(subw + c8 + 4);
            const float lam = expf(wave_sum(lq1[lane] * lk1[lane])) - expf(wave_sum(lq2[lane] * lk2[lane])) + LAM_INIT;
#pragma unroll 2
            for (int it = 0; it < 8; ++it) { const int row = it * 4 + rsub; const float rl = __builtin_amdgcn_rcpf(li_l[row]);
                const f32x4 v0 = *(const LAS f32x4*)(stg + row * 128 + c8) * rl, v1 = *(const LAS f32x4*)(stg + row * 128 + c8 + 4) * rl;
                const f32x4 d0 = *(const f32x4*)(scrw + row * 128 + c8) - lam * v0, d1 = *(const f32x4*)(scrw + row * 128 + c8 + 4) - lam * v1;
                float ss = (d0[0] * d0[0] + d0[1] * d0[1]) + (d0[2] * d0[2] + d0[3] * d0[3]) + (d1[0] * d1[0] + d1[1] * d1[1]) + (d1[2] * d1[2] + d1[3] * d1[3]);
                ss += __shfl_xor(ss, 1); ss += __shfl_xor(ss, 2); ss += __shfl_xor(ss, 4); ss += __shfl_xor(ss, 8);
                const float rs = __builtin_amdgcn_rsqf(ss * (1.f / 128.f) + NORM_EPS) * (1.f - LAM_INIT);
                f32x4 g0, g1; unpack8(*(const v4u*)(GA + (row0 + row) * 512 + h * 128 + c8), g0, g1);
                *(v4u*)(Y + (row0 + row) * 1024 + h * 128 + c8) = pack8(d0 * rs * w0 * g0, d1 * rs * w1 * g1); }
        }
        __syncthreads();
    }
}
__device__ __forceinline__ void unit_B(int b, int head, int qb, const bf16_t* QB, const bf16_t* KB, const bf16_t* VB, const bf16_t* GB, bf16_t* Y, LAS char* lds) {
    f32x16 o[2]; float l;
    { const int wid = __builtin_amdgcn_readfirstlane(threadIdx.x >> 6); const size_t row0 = (size_t)b * SEQ + qb * 256 + wid * 32; const int kvh = head >> 2;
      ATT_BODY_B<64, false, 512, 128, 128>(QB + row0 * 512 + head * 64, KB + (size_t)b * SEQ * 128 + kvh * 64, VB + (size_t)b * SEQ * 128 + kvh * 64, qb * 256 + wid * 32, 0, 0.f, o, l, lds); }
    int tid2 = threadIdx.x; asm volatile("" : "+v"(tid2));
    const int lane = tid2 & 63, wid = __builtin_amdgcn_readfirstlane(tid2 >> 6), rsub = lane >> 3, c8 = (lane & 7) * 8;
    LAS float* stg = (LAS float*)(lds + wid * 16384); LAS float* li_l = (LAS float*)(lds + LDS_WS) + wid * 64; const size_t row0 = (size_t)b * SEQ + qb * 256 + wid * 32;
    stage_o<2>(o, l, stg, li_l, lane & 31, lane >> 5);
#pragma unroll 2
    for (int it = 0; it < 4; ++it) { const int row = it * 8 + rsub; const float rl = __builtin_amdgcn_rcpf(li_l[row]);
        const f32x4 v0 = *(const LAS f32x4*)(stg + row * 64 + c8) * rl, v1 = *(const LAS f32x4*)(stg + row * 64 + c8 + 4) * rl;
        f32x4 g0, g1; unpack8(*(const v4u*)(GB + (row0 + row) * 512 + head * 64 + c8), g0, g1);
        *(v4u*)(Y + (row0 + row) * 1024 + 512 + head * 64 + c8) = pack8(v0 * g0, v1 * g1); }
    __syncthreads();
}
#undef SBAR
}

#define XB_TMO      128
#define XB_XCNT(j)  (256  + 64 * (j))
#define XB_XSUB(j)  (1280 + 64 * (j))
#define XB_XGEN(j)  (2304 + 64 * (j))
#define XB_TOP      3328
#define XB_TOPGEN   3392
#define XCD_BAR_WORDS 3456
#define XB_SPIN_CAP (1u << 18)

__device__ __forceinline__ unsigned xb_ld(unsigned* p)              { return __hip_atomic_load(p, __ATOMIC_RELAXED, __HIP_MEMORY_SCOPE_AGENT); }
__device__ __forceinline__ unsigned xb_add(unsigned* p, unsigned v) { return __hip_atomic_fetch_add(p, v, __ATOMIC_RELAXED, __HIP_MEMORY_SCOPE_AGENT); }
__device__ __forceinline__ unsigned xb_xcc_id() { return (unsigned)__builtin_amdgcn_s_getreg((3 << 11) | 20) & 0xFu; }
#define XB_SPIN(cond, bar) do { unsigned _sp = 0; while (cond) { __builtin_amdgcn_s_sleep(1); \
    if ((++_sp & 255u) == 0u) { if (xb_ld(&(bar)[XB_TMO])) break; if (_sp > XB_SPIN_CAP) { atomicAdd(&(bar)[XB_TMO], 1u); break; } } } } while (0)

struct XcdBarrier {
    unsigned* bar; unsigned x;
    volatile LAS unsigned* st;
};

__device__ __forceinline__ XcdBarrier xcd_barrier_post(unsigned* bar, volatile LAS unsigned* st) {
    XcdBarrier b; b.bar = bar; b.x = xb_xcc_id(); b.st = st;
    if (threadIdx.x == 0) (void)xb_add(&bar[XB_XCNT(b.x)], 1u);
    return b;
}
__device__ __forceinline__ void xcd_barrier_complete(unsigned* bar, unsigned x, unsigned& nloc, unsigned& nx) {
    const unsigned G = gridDim.x * gridDim.y * gridDim.z;
    unsigned sum, cnt, mine, sp = 0u;
    for (;;) {
        sum = 0u; cnt = 0u; mine = 0u;
#pragma unroll
        for (unsigned j = 0; j < 16; ++j) { const unsigned c = xb_ld(&bar[XB_XCNT(j)]); sum += c; cnt += (c > 0u) ? 1u : 0u; mine = (j == x) ? c : mine; }
        if (sum == G) break;
        __builtin_amdgcn_s_sleep(1);
        if ((++sp & 255u) == 0u) { if (xb_ld(&bar[XB_TMO])) break; if (sp > XB_SPIN_CAP) { atomicAdd(&bar[XB_TMO], 1u); break; } }
    }
    nloc = mine > 0u ? mine : 1u; nx = cnt > 0u ? cnt : 1u;
}

__device__ __forceinline__ void xcd_barrier(const XcdBarrier& b) {
    asm volatile("s_waitcnt vmcnt(0)" ::: "memory");
    __syncthreads();
    if (threadIdx.x == 0) {
        unsigned* bar = b.bar;
        __builtin_amdgcn_s_waitcnt(0);
        unsigned nloc = b.st[0], nx = b.st[1];
        if (nloc == 0u) { xcd_barrier_complete(bar, b.x, nloc, nx); b.st[0] = nloc; b.st[1] = nx; }
        const unsigned old = xb_add(&bar[XB_XSUB(b.x)], 1u);
        const unsigned gen = old / nloc;
        if (old + 1u == (gen + 1u) * nloc) {
            __builtin_amdgcn_fence(__ATOMIC_RELEASE, "agent");
            asm volatile("s_waitcnt vmcnt(0)" ::: "memory");
            const unsigned og = xb_add(&bar[XB_TOP], 1u);
            const unsigned tg = og / nx;
            if (og + 1u == (tg + 1u) * nx) xb_add(&bar[XB_TOPGEN], 1u);
            else XB_SPIN(xb_ld(&bar[XB_TOPGEN]) == tg, bar);
            __builtin_amdgcn_fence(__ATOMIC_ACQUIRE, "agent");
            xb_add(&bar[XB_XGEN(b.x)], 1u);
            asm volatile("s_waitcnt vmcnt(0)" ::: "memory");
        } else {
            XB_SPIN(xb_ld(&bar[XB_XGEN(b.x)]) == gen, bar);
            __builtin_amdgcn_fence(__ATOMIC_ACQUIRE, "agent");
            asm volatile("s_waitcnt vmcnt(0)" ::: "memory");
        }
    }
    __syncthreads();
}

constexpr size_t MiB = 1u << 20;
constexpr size_t WS_CTL = 0, CTL_ZERO_BYTES = 64 * 1024;
constexpr size_t WS_MODP = 1 * MiB;
constexpr size_t WS_MODF = 2 * MiB;
constexpr size_t WS_TAB = 2 * MiB + 64 * 1024;
constexpr size_t WS_WIN = 4 * MiB, WS_WOUT = 12 * MiB;
constexpr size_t WS_H = 16 * MiB;
constexpr size_t WS_QA = 48 * MiB, WS_KA = 64 * MiB, WS_VA = 80 * MiB, WS_GA = 96 * MiB;
constexpr size_t WS_QB = 112 * MiB, WS_KB = 128 * MiB, WS_VB = 132 * MiB, WS_GB = 136 * MiB;
constexpr size_t WS_QBR = 152 * MiB, WS_KBR = 184 * MiB;
constexpr size_t WS_O0 = 192 * MiB;
constexpr size_t WS_END = 224 * MiB;

constexpr int NWAVES = 8, LDS_BYTES = 147456;
constexpr int LDS_CTL = 147456 - 256;
constexpr int CW_BAR = 4096;
constexpr int LDS_MISC = 131072;

struct Args { const float *x, *c, *w_ada, *b_ada, *norm_w, *w_in, *lq1, *lk1, *lq2, *lk2, *subln_w, *qn_w, *kn_w, *w_out, *fn_w; float* out; unsigned char* ws; int ph_lo, ph_hi; };

__device__ __forceinline__ void transpose_item(const float* W, int K, int N, bf16_t* WT, LAS float* scr, int item, int lane) {
    const int nblk = N / 32, kb = item / nblk, nb = item % nblk, k0 = 64 * kb, n0 = 32 * nb;
#pragma unroll 8
    for (int i = 0; i < 32; ++i) { const int kk = 2 * i + (lane >> 5); scr[kk * 33 + (lane & 31)] = W[(size_t)(k0 + kk) * N + n0 + (lane & 31)]; }
    asm volatile("s_waitcnt lgkmcnt(0)" ::: "memory");
    const int c = lane & 7;
#pragma unroll
    for (int j = 0; j < 4; ++j) { const int n = (lane >> 3) + 8 * j; const LAS float* s = scr + (8 * c) * 33 + n;
        v4u o; o.x = cvtpk(s[0 * 33], s[1 * 33]); o.y = cvtpk(s[2 * 33], s[3 * 33]); o.z = cvtpk(s[4 * 33], s[5 * 33]); o.w = cvtpk(s[6 * 33], s[7 * 33]);
        *(v4u*)(WT + (size_t)(n0 + n) * K + k0 + 8 * c) = o; }
    asm volatile("s_waitcnt lgkmcnt(0)" ::: "memory");
}

__global__ void __launch_bounds__(NWAVES * 64, 2) mega(Args a) {
    extern __shared__ __attribute__((aligned(16))) unsigned char lds_raw[];
    LAS unsigned char* lds = (LAS unsigned char*)lds_raw;
    const int tid = threadIdx.x, lane = tid & 63; const int wid = __builtin_amdgcn_readfirstlane(tid >> 6);
    const int G = gridDim.x, bx = blockIdx.x, vcu = (G % 8 == 0) ? (bx % 8) * (G / 8) + bx / 8 : bx;
    const int gw = vcu * NWAVES + wid, NGW = G * NWAVES;
    unsigned char* ws = a.ws;
#define WS_PTRS() unsigned char* wsp_ = a.ws; asm volatile("" : "+s"(wsp_)); __attribute__((address_space(1))) unsigned char* wsp = (__attribute__((address_space(1))) unsigned char*)wsp_; \
    float* modp = (float*)(wsp + WS_MODP); float* modf = (float*)(wsp + WS_MODF); f32x2* tab = (f32x2*)(wsp + WS_TAB); \
    bf16_t* WIN = (bf16_t*)(wsp + WS_WIN); bf16_t* WOUT = (bf16_t*)(wsp + WS_WOUT); bf16_t* H = (bf16_t*)(wsp + WS_H); bf16_t* Y = H; \
    bf16_t *QA = (bf16_t*)(wsp + WS_QA), *KA = (bf16_t*)(wsp + WS_KA), *VA = (bf16_t*)(wsp + WS_VA), *GA = (bf16_t*)(wsp + WS_GA); \
    bf16_t *QB = (bf16_t*)(wsp + WS_QB), *KB = (bf16_t*)(wsp + WS_KB), *VB = (bf16_t*)(wsp + WS_VB), *GB = (bf16_t*)(wsp + WS_GB); \
    float *QBR = (float*)(wsp + WS_QBR), *KBR = (float*)(wsp + WS_KBR); \
    (void)modp; (void)modf; (void)tab; (void)WIN; (void)WOUT; (void)H; (void)Y; (void)QA; (void)KA; (void)VA; (void)GA; (void)QB; (void)KB; (void)VB; (void)GB; (void)QBR; (void)KBR
    const int lo = a.ph_lo, hi_ = a.ph_hi;
    volatile LAS unsigned* MISC = (volatile LAS unsigned*)(lds + LDS_CTL);
    if (tid < 2) MISC[tid] = 0u;
    __syncthreads();
    XcdBarrier bar = xcd_barrier_post((unsigned*)(ws + WS_CTL) + CW_BAR, MISC);
#ifndef PH_MASK
#define PH_MASK 0x7f
#endif
#define IN(k) (((PH_MASK >> (k)) & 1) && lo <= (k) && (k) < hi_)
#define SEAM(k) do { if (IN(k) && IN((k) + 1)) xcd_barrier(bar); } while (0)

    if (IN(0)) { WS_PTRS();
        for (int it = gw; it < 384; it += NGW) {
            const int s = it / 12, col = (it % 12) * 256 + lane * 4;
            f32x4 a0 = {0.f, 0.f, 0.f, 0.f}, a1 = a0;
#pragma unroll 8
            for (int k = s * 32; k < s * 32 + 32; ++k) { const f32x4 w = *(const f32x4*)(a.w_ada + (size_t)k * 3072 + col);
                const float c0 = a.c[k], c1 = a.c[1024 + k]; a0 += pg8::silu_f(c0) * w; a1 += pg8::silu_f(c1) * w; }
            *(f32x4*)(modp + (size_t)(s * 2 + 0) * 3072 + col) = a0; *(f32x4*)(modp + (size_t)(s * 2 + 1) * 3072 + col) = a1;
        }
        { const int g = vcu * 512 + tid;
          if (g < 3072) { const int p = g >> 4, i = g & 15; const float freq = 1.0f / powf(10000.0f, (float)i * 2.0f / 32.0f);
              const float ang = (float)(p < 128 ? p : p - 128) * freq; float sn, cs; sincosf(ang, &sn, &cs); tab[g] = (f32x2){cs, sn}; } }
        LAS float* scr = (LAS float*)(lds + wid * 16384);
        constexpr int I_IN = (DM / 64) * (NPROJ / 32), I_OUT = (DM / 64) * (DM / 32);
        for (int it = gw; it < I_IN + I_OUT; it += NGW) {
            if (it < I_IN) transpose_item(a.w_in, DM, NPROJ, WIN, scr, it, lane); else transpose_item(a.w_out, DM, DM, WOUT, scr, it - I_IN, lane);
        }
    }
    SEAM(0);
    if (IN(1)) { WS_PTRS();
        LAS float* gsh = (LAS float*)(lds + LDS_MISC);
        for (int chunk = bx; chunk < 256; chunk += G) {
            const int b = chunk >> 7;
            for (int j = tid; j < 2048; j += 512) { const int col = j & 1023, midx = (j < 1024) ? 1024 + col : col;
                float v = a.b_ada[midx];
#pragma unroll 8
                for (int s = 0; s < 32; ++s) v += modp[(size_t)(s * 2 + b) * 3072 + midx];
                gsh[j] = (j < 1024) ? a.norm_w[col] * (1.f + v) : v; }
            if (chunk < 12) { const int j = chunk * 512 + tid, bb = j / 3072, idx = j % 3072; float v = a.b_ada[idx];
#pragma unroll 8
                for (int s = 0; s < 32; ++s) v += modp[(size_t)(s * 2 + bb) * 3072 + idx];
                modf[j] = v; }
            __syncthreads();
            for (int i = 0; i < 8; ++i) { const size_t row = (size_t)chunk * 64 + wid * 8 + i;
                const f32x4* xr = (const f32x4*)(a.x + row * DM) + lane; f32x4 v[4]; float s = 0.f;
#pragma unroll
                for (int j = 0; j < 4; ++j) { v[j] = xr[64 * j]; s += (v[j].x * v[j].x + v[j].y * v[j].y) + (v[j].z * v[j].z + v[j].w * v[j].w); }
                const float rstd = __builtin_amdgcn_rsqf(wave_sum(s) * (1.f / DM) + NORM_EPS);
                unsigned long long* o8 = (unsigned long long*)(H + row * DM) + lane;
#pragma unroll
                for (int j = 0; j < 4; ++j) { const int c0 = 4 * lane + 256 * j; const f32x4 g = *(const LAS f32x4*)(gsh + c0), sh = *(const LAS f32x4*)(gsh + 1024 + c0);
                    const f32x4 hv = v[j] * rstd * g + sh; o8[64 * j] = (unsigned long long)cvtpk(hv.x, hv.y) | ((unsigned long long)cvtpk(hv.z, hv.w) << 32); } }
            __syncthreads();
        }
    }
    SEAM(1);
    if (IN(2)) { WS_PTRS();
        pg8::Gemm g{H, WIN, M, NPROJ, DM}; pg8::StaticOrder S; S.init(M, NPROJ, G, bx);
        pg8::EpiProj E{QA, KA, VA, GA, VB, GB, QBR, KBR, C2};
#ifdef DUP_P2
        for (int rep_ = 0; rep_ < 2; ++rep_)
#endif
        pg8::gemm_phase<pg8::EpiProj, pg8::StaticOrder, true, true>(lds, g, S, E);
    }
    SEAM(2);
    if (IN(3)) { WS_PTRS();
        for (int it = gw; it < M * 10; it += NGW) { const int row = it / 10, hh = it % 10;
            const float raw = hh < 8 ? QBR[(size_t)row * 512 + hh * 64 + lane] : KBR[(size_t)row * 128 + (hh - 8) * 64 + lane];
            const float rstd = __builtin_amdgcn_rsqf(wave_sum(raw * raw) * (1.f / 64.f) + NORM_EPS);
            const float y = raw * rstd * (hh < 8 ? a.qn_w[lane] : a.kn_w[lane]);
            const int t = row & (SEQ - 1), pos = lane < 32 ? (t >> 6) : 128 + (t & 63);
            const f32x2 cs = tab[pos * 16 + (lane & 15)]; const float pr = __shfl_xor(y, 16);
            const float ov = (lane & 16) ? y * cs.x + pr * cs.y : y * cs.x - pr * cs.y;
            if (hh < 8) QB[(size_t)row * 512 + hh * 64 + lane] = f2bf(ov * C2); else KB[(size_t)row * 128 + (hh - 8) * 64 + lane] = f2bf(ov); }
    }
    SEAM(3);
    if (IN(4)) { WS_PTRS();
        float* scr = (float*)(wsp + WS_O0) + (size_t)bx * 32768;
        for (int u = vcu; u < 256; u += G) {
#ifndef NO_A
#ifdef DUP_A
            for (int rep_ = 0; rep_ < 2; ++rep_)
#endif
            att::unit_A(u >> 7, (u >> 5) & 3, u & 31, QA, KA, VA, GA, Y, a.subln_w, a.lq1, a.lk1, a.lq2, a.lk2, scr, (LAS char*)lds);
#endif
#ifndef NO_B
#ifdef DUP_B
            for (int rep_ = 0; rep_ < 2; ++rep_)
#endif
#pragma nounroll
            for (int i = 0; i < 2; ++i) { const int ub = u * 2 + i; att::unit_B(ub >> 8, (ub >> 5) & 7, ub & 31, QB, KB, VB, GB, Y, (LAS char*)lds); }
#endif
        }
    }
    SEAM(4);
    if (IN(5)) { WS_PTRS();
        pg8::Gemm g{Y, WOUT, M, DM, DM}; pg8::StaticOrder S; S.init(M, DM, G, bx);
        pg8::EpiOut E{a.x, a.out, modf};
        pg8::gemm_phase<pg8::EpiOut, pg8::StaticOrder, true, true>(lds, g, S, E);
    }
    SEAM(5);
    if (IN(6)) { WS_PTRS();
        for (int row = gw; row < M; row += NGW) {
            f32x4* xr = (f32x4*)(a.out + (size_t)row * DM) + lane; f32x4 v[4]; float s = 0.f;
#pragma unroll
            for (int j = 0; j < 4; ++j) { v[j] = xr[64 * j]; s += (v[j].x * v[j].x + v[j].y * v[j].y) + (v[j].z * v[j].z + v[j].w * v[j].w); }
            const float rstd = __builtin_amdgcn_rsqf(wave_sum(s) * (1.f / DM) + NORM_EPS);
#pragma unroll
            for (int j = 0; j < 4; ++j) { const f32x4 w = *((const f32x4*)a.fn_w + lane + 64 * j); xr[64 * j] = v[j] * rstd * w; }
        }
    }
#undef IN
#undef SEAM
}

extern "C" void kernel_launch(void* const* d_in, const int* in_sizes, int n_in, void* d_out, int out_size, void* d_ws, size_t ws_size, hipStream_t stream) {
    static int grid = 0;
    if (grid == 0) {
        if (n_in != 15 || in_sizes[0] != M * DM || out_size != M * DM || ws_size < WS_END) { fprintf(stderr, "kernel_launch: unexpected shapes (n_in %d, in0 %d, out %d, ws %zu)\n", n_in, n_in > 0 ? in_sizes[0] : -1, out_size, ws_size); grid = -1; return; }
        int dev = 0, cus = 0, per_cu = 0;
        hipGetDevice(&dev); hipDeviceGetAttribute(&cus, hipDeviceAttributeMultiprocessorCount, dev);
        if (hipFuncSetAttribute((const void*)mega, hipFuncAttributeMaxDynamicSharedMemorySize, LDS_BYTES) != hipSuccess) { fprintf(stderr, "kernel_launch: hipFuncSetAttribute failed\n"); grid = -1; return; }
        if (hipOccupancyMaxActiveBlocksPerMultiprocessor(&per_cu, (const void*)mega, NWAVES * 64, LDS_BYTES) != hipSuccess || per_cu < 1) { fprintf(stderr, "kernel_launch: occupancy query failed (%d)\n", per_cu); (void)hipGetLastError(); per_cu = 1; }
        grid = cus * per_cu; if (grid > 256) grid = 256;
    }
    if (grid < 0) return;
    Args a{};
    a.x = (const float*)d_in[0]; a.c = (const float*)d_in[1]; a.w_ada = (const float*)d_in[2]; a.b_ada = (const float*)d_in[3]; a.norm_w = (const float*)d_in[4]; a.w_in = (const float*)d_in[5];
    a.lq1 = (const float*)d_in[6]; a.lk1 = (const float*)d_in[7]; a.lq2 = (const float*)d_in[8]; a.lk2 = (const float*)d_in[9]; a.subln_w = (const float*)d_in[10];
    a.qn_w = (const float*)d_in[11]; a.kn_w = (const float*)d_in[12]; a.w_out = (const float*)d_in[13]; a.fn_w = (const float*)d_in[14];
    a.out = (float*)d_out; a.ws = (unsigned char*)d_ws; a.ph_lo = 0; a.ph_hi = 7;
    if (hipMemsetAsync((char*)d_ws + WS_CTL, 0, CTL_ZERO_BYTES, stream) != hipSuccess) { fprintf(stderr, "kernel_launch: hipMemsetAsync failed\n"); return; }
    hipLaunchKernelGGL(mega, dim3(grid), dim3(NWAVES * 64), LDS_BYTES, stream, a);
    const hipError_t e = hipPeekAtLastError();
    if (e != hipSuccess) fprintf(stderr, "kernel_launch: launch failed: %s (grid %d)\n", hipGetErrorName(e), grid);
}
```

```cpp
#include <hip/hip_runtime.h>
#include <cstdio>
#include <cstdint>

namespace pg8 {
#define PG8_LAS __attribute__((address_space(3)))
typedef unsigned short bf16_t;
typedef short bf16x8 __attribute__((ext_vector_type(8)));
typedef float f32x4 __attribute__((ext_vector_type(4)));
typedef unsigned u32x4 __attribute__((ext_vector_type(4)));
constexpr int BM = 256, BK = 64, HALF = 128, HTB = HALF * BK * 2  , STAGE_BYTES = 8 * HTB, NXCD = 8, WGM = 8;

__host__ __device__ __forceinline__ int lds_byte(int r, int c) { const int st = (r >> 4) * 2 + (c >> 5), rr = r & 15, cc = c & 31, ob = rr * 64 + cc * 2; return st * 1024 + (ob ^ (((ob >> 9) & 1) << 5)); }
__host__ __device__ __forceinline__ void stage_rc(int b, int& R, int& C) { const int st = b / 1024, sb = b % 1024, swz = sb ^ (((sb >> 9) & 1) << 5); R = (st >> 1) * 16 + swz / 64; C = (st & 1) * 32 + (swz % 64) / 2; }
__host__ __device__ __forceinline__ int perm32(int rho) { const int n = rho >> 4, i = rho & 15; return 8 * (i >> 2) + 4 * n + (i & 3); }

struct Unit { int pm, pn; };
struct Gemm { const bf16_t* A; const bf16_t* Bt; int M, N, K; };

struct StaticOrder {
    int nM, nN, nwg, G, c;
    __host__ __device__ void init(int M, int N, int G_, int c_) { nM = M / BM; nN = N / BM; nwg = nM * nN; G = G_; c = c_; }
    __host__ __device__ bool next(int i, Unit& u) const {
        const long L = (long)i * G + c; if (L >= nwg) return false;
        int wgid = (int)L; { const int q = nwg / NXCD, r = nwg % NXCD, xcd = wgid % NXCD, off = wgid / NXCD; wgid = (xcd < r ? xcd * (q + 1) : r * (q + 1) + (xcd - r) * q) + off; }
        const int nig = WGM * nN, gid = wgid / nig, fm = gid * WGM, gsz = (nM - fm) < WGM ? (nM - fm) : WGM;
        u.pm = fm + ((wgid % nig) % gsz); u.pn = (wgid % nig) / gsz; return true;
    }
    __device__ __forceinline__ void a_ready(const Unit&) const {}
    __device__ __forceinline__ void done(const Unit&) const {}
};

__device__ __forceinline__ unsigned cvt_pk_bf16(float lo, float hi) { unsigned r; asm volatile("v_cvt_pk_bf16_f32 %0, %1, %2" : "=v"(r) : "v"(lo), "v"(hi)); return r; }
typedef float f32x2 __attribute__((ext_vector_type(2)));

__device__ __forceinline__ float silu_f(float v) { return v * __builtin_amdgcn_rcpf(1.f + __builtin_amdgcn_exp2f(-1.4426950408889634f * v)); }
struct EpiProj {
    static constexpr bool PERM = true, AFTER_DRAIN = false;
    bf16_t *QA, *KA, *VA, *GA, *VB, *GB; float *QBR, *KBR; float qscale;
    __device__ __forceinline__ void operator()(const f32x4 (&acc)[2][2][4][2], const Unit& u, int wr, int wc, int fr, int fq) const {
        const int row0 = u.pm * BM + wr * 64 + fr, cin = wc * 32 + 8 * fq;
#pragma unroll
        for (int bj = 0; bj < 2; ++bj) {
            const int blk = u.pn * 2 + bj;
            int mode = 0, ld = 512, c0 = 0; bf16_t* d16 = nullptr; float* d32 = nullptr;
            if (blk < 4)       { mode = 1; d16 = QA; c0 = blk * 128 + cin; }
            else if (blk < 8)  { mode = 0; d16 = KA; c0 = (blk - 4) * 128 + cin; }
            else if (blk < 12) { mode = 0; d16 = VA; c0 = (blk - 8) * 128 + cin; }
            else if (blk < 16) { mode = 2; d16 = GA; c0 = (blk - 12) * 128 + cin; }
            else if (blk < 20) { mode = 3; d32 = QBR; c0 = (blk - 16) * 128 + cin; }
            else if (blk == 20) { mode = 3; d32 = KBR; ld = 128; c0 = cin; }
            else if (blk == 21) { mode = 0; d16 = VB; ld = 128; c0 = cin; }
            else               { mode = 2; d16 = GB; c0 = (blk - 22) * 128 + cin; }
#pragma unroll
            for (int ai = 0; ai < 2; ++ai)
#pragma unroll
                for (int m = 0; m < 4; ++m) {
                    const size_t off = (size_t)(row0 + ai * HALF + m * 16) * ld + c0;
                    f32x4 v0 = acc[ai][bj][m][0], v1 = acc[ai][bj][m][1];
                    if (mode == 3) { *(f32x4*)(d32 + off) = v0; *(f32x4*)(d32 + off + 4) = v1; }
                    else {
                        if (mode == 1) { v0 = v0 * qscale; v1 = v1 * qscale; }
                        if (mode == 2) { v0 = (f32x4){silu_f(v0[0]), silu_f(v0[1]), silu_f(v0[2]), silu_f(v0[3])}; v1 = (f32x4){silu_f(v1[0]), silu_f(v1[1]), silu_f(v1[2]), silu_f(v1[3])}; }
                        u32x4 w; w.x = cvt_pk_bf16(v0[0], v0[1]); w.y = cvt_pk_bf16(v0[2], v0[3]); w.z = cvt_pk_bf16(v1[0], v1[1]); w.w = cvt_pk_bf16(v1[2], v1[3]);
                        *(u32x4*)(d16 + off) = w;
                    }
                }
        }
    }
};
struct EpiOut {
    static constexpr bool PERM = true, AFTER_DRAIN = false;
    const float* x; float* out; const float* modf;
    __device__ __forceinline__ void operator()(const f32x4 (&acc)[2][2][4][2], const Unit& u, int wr, int wc, int fr, int fq) const {
        const int row0 = u.pm * BM + wr * 64 + fr, b = u.pm >> 5;
#pragma unroll
        for (int bj = 0; bj < 2; ++bj) {
            const int col0 = u.pn * BM + bj * HALF + wc * 32 + 8 * fq;
            const f32x4 g0 = *(const f32x4*)(modf + b * 3072 + 2048 + col0), g1 = *(const f32x4*)(modf + b * 3072 + 2048 + col0 + 4);
#pragma unroll
            for (int ai = 0; ai < 2; ++ai)
#pragma unroll
                for (int m = 0; m < 4; ++m) {
                    const size_t off = (size_t)(row0 + ai * HALF + m * 16) * 1024 + col0;
                    const f32x4 x0 = *(const f32x4*)(x + off), x1 = *(const f32x4*)(x + off + 4);
                    *(f32x4*)(out + off) = x0 + g0 * acc[ai][bj][m][0]; *(f32x4*)(out + off + 4) = x1 + g1 * acc[ai][bj][m][1];
                }
        }
    }
};

template <class Epi, class Sched, bool ALIGN_EPI = false, bool SP2 = false>
__device__ __forceinline__ void gemm_phase(PG8_LAS unsigned char* lds, const Gemm g, const Sched& S, const Epi& E) {
    const int tid = threadIdx.x, wid = __builtin_amdgcn_readfirstlane(tid >> 6), lane = tid & 63, wr = wid >> 2, wc = wid & 3, fr = lane & 15, fq = lane >> 4;
    const int K = g.K, nt = K / BK;
    unsigned voffA[2], voffB[2];
#pragma unroll
    for (int i = 0; i < 2; ++i) { int R, C; stage_rc(tid * 16 + i * 8192, R, C); const int Rb = Epi::PERM ? ((R & ~31) + perm32(R & 31)) : R;
        voffA[i] = (unsigned)(R * K + C) * 2u; voffB[i] = (unsigned)(Rb * K + C) * 2u; }
    const size_t kstep = (size_t)(BK * 2);
    const size_t hstep = (size_t)HALF * K * 2;
    const size_t tstep = 2 * hstep;
    const unsigned ldsw = (unsigned)wid * 1024u;
    const int aoff = lds_byte(wr * 64 + fr, fq * 8), boff = lds_byte(wc * 32 + fr, fq * 8);
#define PG8_SA(b, h) (((b) * 2 + (h)) * HTB)
#define PG8_SB(b, h) ((4 + (b) * 2 + (h)) * HTB)
#define PG8_STAGE(bufoff, gbase, voff) do { _Pragma("unroll") for (int _i = 0; _i < 2; ++_i) \
        __builtin_amdgcn_global_load_lds((const unsigned*)((const char*)(gbase) + (voff)[_i]), (PG8_LAS unsigned*)(lds + (bufoff) + ldsw + _i * 8192), 16, 0, 0); } while (0)
#define PG8_LDA(dst, b, h) do { _Pragma("unroll") for (int m = 0; m < 4; ++m) _Pragma("unroll") for (int k = 0; k < 2; ++k) dst[m][k] = *(const PG8_LAS bf16x8*)(lds + PG8_SA(b, h) + aoff + m * 2048 + k * 1024); } while (0)
#define PG8_LDB(dst, b, h) do { _Pragma("unroll") for (int n = 0; n < 2; ++n) _Pragma("unroll") for (int k = 0; k < 2; ++k) dst[n][k] = *(const PG8_LAS bf16x8*)(lds + PG8_SB(b, h) + boff + n * 2048 + k * 1024); } while (0)
#define PG8_MMA(ai, bj, At, Bt) do { __builtin_amdgcn_s_setprio(1); _Pragma("unroll") for (int m = 0; m < 4; ++m) _Pragma("unroll") for (int n = 0; n < 2; ++n) _Pragma("unroll") for (int k = 0; k < 2; ++k) \
        acc[ai][bj][m][n] = __builtin_amdgcn_mfma_f32_16x16x32_bf16(Bt[n][k], At[m][k], acc[ai][bj][m][n], 0, 0, 0); __builtin_amdgcn_s_setprio(0); } while (0)
#define PG8_WAIT_V(n) asm volatile("s_waitcnt vmcnt(" #n ")" ::: "memory")
#define PG8_WAIT_L(n) asm volatile("s_waitcnt lgkmcnt(" #n ")" ::: "memory")
#define PG8_BAR __builtin_amdgcn_s_barrier()
#define PG8_SCHED __builtin_amdgcn_sched_barrier(0)
    Unit cur, nxt; int ui = 0;
    if (!S.next(0, cur)) return;
    f32x4 acc[2][2][4][2];
#pragma unroll
    for (int a = 0; a < 2; ++a)
#pragma unroll
        for (int b = 0; b < 2; ++b)
#pragma unroll
            for (int m = 0; m < 4; ++m)
#pragma unroll
                for (int n = 0; n < 2; ++n) acc[a][b][m][n] = (f32x4){0.f, 0.f, 0.f, 0.f};
    bf16x8 At[4][2], B0[2][2], B1[2][2];
    const char* cA = (const char*)g.A + (size_t)cur.pm * tstep; const char* cB = (const char*)g.Bt + (size_t)cur.pn * tstep;
    S.a_ready(cur);
    if constexpr (SP2) {
        PG8_STAGE(PG8_SB(0, 0), cB, voffB); PG8_STAGE(PG8_SB(0, 1), cB + hstep, voffB); PG8_STAGE(PG8_SA(0, 0), cA, voffA); PG8_STAGE(PG8_SA(0, 1), cA + hstep, voffA);
        if (wr == 1) PG8_BAR;
        PG8_WAIT_V(2); PG8_BAR;
        PG8_STAGE(PG8_SB(1, 0), cB + kstep, voffB); PG8_STAGE(PG8_SA(1, 0), cA + kstep, voffA); PG8_STAGE(PG8_SB(1, 1), cB + hstep + kstep, voffB);
        PG8_WAIT_V(6); PG8_BAR;
    } else {
        PG8_STAGE(PG8_SB(0, 0), cB, voffB); PG8_STAGE(PG8_SA(0, 0), cA, voffA); PG8_STAGE(PG8_SB(0, 1), cB + hstep, voffB); PG8_STAGE(PG8_SA(0, 1), cA + hstep, voffA);
        if (wr == 1) PG8_BAR;
        PG8_WAIT_V(4); PG8_BAR;
        PG8_STAGE(PG8_SB(1, 0), cB + kstep, voffB); PG8_STAGE(PG8_SA(1, 0), cA + kstep, voffA); PG8_STAGE(PG8_SB(1, 1), cB + hstep + kstep, voffB);
        PG8_WAIT_V(6); PG8_BAR;
    }
    for (;;) {
        const bool has_next = S.next(ui + 1, nxt);
        const char* nA = has_next ? (const char*)g.A + (size_t)nxt.pm * tstep : cA; const char* nB = has_next ? (const char*)g.Bt + (size_t)nxt.pn * tstep : cB;
        for (int t = 0; t < nt; t += 2) {
            const bool last = (t == nt - 2);
            const char* a1 = cA + (size_t)(t + 1) * kstep;
            const char* a2 = last ? nA : cA + (size_t)(t + 2) * kstep; const char* b2 = last ? nB : cB + (size_t)(t + 2) * kstep;
            const char* a3 = a2 + kstep; const char* b3 = b2 + kstep;
            if (last && has_next) S.a_ready(nxt);
            if constexpr (SP2) {
            PG8_LDB(B0, 0, 0); PG8_LDB(B1, 0, 1); PG8_SCHED; PG8_LDA(At, 0, 0); PG8_STAGE(PG8_SA(1, 1), a1 + hstep, voffA);
            PG8_WAIT_V(8); PG8_WAIT_L(0); PG8_BAR; PG8_MMA(0, 0, At, B0); PG8_MMA(0, 1, At, B1); PG8_BAR; PG8_SCHED;
            PG8_LDA(At, 0, 1); PG8_STAGE(PG8_SB(0, 0), b2, voffB); PG8_STAGE(PG8_SB(0, 1), b2 + hstep, voffB); PG8_STAGE(PG8_SA(0, 0), a2, voffA);
            PG8_WAIT_V(8); PG8_WAIT_L(0); PG8_BAR; PG8_MMA(1, 0, At, B0); PG8_MMA(1, 1, At, B1); PG8_BAR; PG8_SCHED;
            PG8_LDB(B0, 1, 0); PG8_LDB(B1, 1, 1); PG8_SCHED; PG8_LDA(At, 1, 0); PG8_STAGE(PG8_SA(0, 1), a2 + hstep, voffA);
            PG8_WAIT_V(8); PG8_WAIT_L(0); PG8_BAR; PG8_MMA(0, 0, At, B0); PG8_MMA(0, 1, At, B1); PG8_BAR; PG8_SCHED;
            PG8_LDA(At, 1, 1); PG8_STAGE(PG8_SB(1, 0), b3, voffB); PG8_STAGE(PG8_SB(1, 1), b3 + hstep, voffB); PG8_STAGE(PG8_SA(1, 0), a3, voffA);
            PG8_WAIT_V(8); PG8_WAIT_L(0); PG8_BAR; PG8_MMA(1, 0, At, B0); PG8_MMA(1, 1, At, B1); PG8_BAR; PG8_SCHED;
            } else {
            PG8_LDB(B0, 0, 0); PG8_SCHED; PG8_LDA(At, 0, 0); PG8_STAGE(PG8_SA(1, 1), a1 + hstep, voffA);
            PG8_WAIT_L(8); PG8_BAR; PG8_WAIT_L(0); PG8_MMA(0, 0, At, B0); PG8_BAR; PG8_SCHED;
            PG8_LDB(B1, 0, 1); PG8_STAGE(PG8_SB(0, 0), b2, voffB);
            PG8_BAR; PG8_WAIT_L(0); PG8_MMA(0, 1, At, B1); PG8_BAR;
            PG8_LDA(At, 0, 1); PG8_STAGE(PG8_SA(0, 0), a2, voffA);
            PG8_BAR; PG8_WAIT_L(0); PG8_MMA(1, 0, At, B0); PG8_BAR; PG8_SCHED;
            PG8_STAGE(PG8_SB(0, 1), b2 + hstep, voffB);
            PG8_WAIT_V(6); PG8_BAR; PG8_MMA(1, 1, At, B1); PG8_BAR;
            PG8_LDB(B0, 1, 0); PG8_SCHED; PG8_LDA(At, 1, 0); PG8_STAGE(PG8_SA(0, 1), a2 + hstep, voffA);
            PG8_WAIT_L(8); PG8_BAR; PG8_WAIT_L(0); PG8_MMA(0, 0, At, B0); PG8_BAR; PG8_SCHED;
            PG8_LDB(B1, 1, 1); PG8_STAGE(PG8_SB(1, 0), b3, voffB);
            PG8_BAR; PG8_WAIT_L(0); PG8_MMA(0, 1, At, B1); PG8_BAR;
            PG8_LDA(At, 1, 1); PG8_STAGE(PG8_SA(1, 0), a3, voffA);
            PG8_BAR; PG8_WAIT_L(0); PG8_MMA(1, 0, At, B0); PG8_BAR; PG8_SCHED;
            PG8_STAGE(PG8_SB(1, 1), b3 + hstep, voffB);
            PG8_WAIT_V(6); PG8_BAR; PG8_MMA(1, 1, At, B1); PG8_BAR;
            }
        }
        if constexpr (ALIGN_EPI) { if (wr == 0) PG8_BAR; }
        if constexpr (!Epi::AFTER_DRAIN) { E(acc, cur, wr, wc, fr, fq); S.done(cur); }
        if (!has_next) break;
#pragma unroll
        for (int a = 0; a < 2; ++a)
#pragma unroll
            for (int b = 0; b < 2; ++b)
#pragma unroll
                for (int m = 0; m < 4; ++m)
#pragma unroll
                    for (int n = 0; n < 2; ++n) acc[a][b][m][n] = (f32x4){0.f, 0.f, 0.f, 0.f};
        cur = nxt; cA = nA; cB = nB; ++ui;
        if constexpr (ALIGN_EPI) { if (wr == 1) PG8_BAR; }
    }
    PG8_WAIT_V(0);
    if constexpr (!ALIGN_EPI) { if (wr == 0) PG8_BAR; }
    PG8_BAR;
    if constexpr (Epi::AFTER_DRAIN) { E.fused(acc, cur, wr, wc, fr, fq, lds, wid, lane); S.done(cur); }
#undef PG8_SA
#undef PG8_SB
#undef PG8_STAGE
#undef PG8_LDA
#undef PG8_LDB
#undef PG8_MMA
#undef PG8_WAIT_V
#undef PG8_WAIT_L
#undef PG8_BAR
#undef PG8_SCHED
}
}

#define LAS __attribute__((address_space(3)))
typedef unsigned short bf16_t;
typedef float f32x4 __attribute__((ext_vector_type(4)));
typedef float f32x2 __attribute__((ext_vector_type(2)));
typedef unsigned v4u __attribute__((ext_vector_type(4)));

constexpr int BATCH = 2, SEQ = 8192, DM = 1024, M = BATCH * SEQ, NPROJ = 3328;
constexpr float NORM_EPS = 1e-6f, LOG2E = 1.4426950408889634f;
constexpr float C2 = 0.125f * LOG2E;
constexpr float LAM_INIT = 0.2f;

__device__ __forceinline__ unsigned cvtpk(float lo, float hi) { typedef __bf16 b2 __attribute__((ext_vector_type(2))); f32x2 v = {lo, hi}; b2 b = __builtin_convertvector(v, b2); return __builtin_bit_cast(unsigned, b); }
__device__ __forceinline__ bf16_t f2bf(float f) { return (bf16_t)(cvtpk(f, 0.f) & 0xffffu); }
__device__ __forceinline__ float bf2f(bf16_t v) { return __uint_as_float((unsigned)v << 16); }
__device__ __forceinline__ float wave_sum(float v) {
#pragma unroll
    for (int o = 1; o < 64; o <<= 1) v += __shfl_xor(v, o);
    return v;
}

#ifndef ATT_BODY_A
#define ATT_BODY_A attn_body
#endif
#ifndef ATT_BODY_B
#define ATT_BODY_B attn_body_p
#endif
namespace att {
typedef short bf16x8 __attribute__((ext_vector_type(8)));
typedef short s16x4 __attribute__((ext_vector_type(4)));
typedef float f32x16 __attribute__((ext_vector_type(16)));
constexpr int NW = 8, QBLK = 32, KVBLK = 64, NT = SEQ / KVBLK;
constexpr float THR = 8.f;
constexpr int SHM_V = 16384, SHM_K = 8192, LDS_V = 0, LDS_K = 2 * SHM_V, LDS_WS = 131072 + 8192;
#define SBAR() __builtin_amdgcn_sched_barrier(0)
#define KSWZ64(row, colB) ((row) * 128 + ((colB) ^ ((((row) >> 1) & 7) << 4)))
#define MFMA32(a, b, c) __builtin_amdgcn_mfma_f32_32x32x16_bf16(a, b, c, 0, 0, 0)
#define MX3(a, b, c) __builtin_fmaxf(__builtin_fmaxf((a), (b)), (c))
__device__ __forceinline__ int crow(int r, int hi) { return (r & 3) + 8 * (r >> 2) + 4 * hi; }
template <int NCB> __device__ __forceinline__ int v_st(int k, int c) { return ((k >> 3) * NCB + (c >> 5)) * 512 + ((k & 7) * 32 + (c & 31)) * 2; }
__device__ __forceinline__ int v_rd_base(int lane) { return ((lane & 3) << 3) | (((lane >> 2) & 3) << 6) | (((lane >> 4) & 1) << 5) | (((lane >> 5) & 1) << 8); }
template <int OFF> __device__ __forceinline__ s16x4 tr_read(unsigned vb) { s16x4 r; asm volatile("ds_read_b64_tr_b16 %0, %1 offset:%2" : "=&v"(r) : "v"(vb), "i"(OFF) : "memory"); return r; }
template <int NCB, int D0> __device__ __forceinline__ void pv_one(f32x16& od, unsigned vb, bf16x8 pa0, bf16x8 pa1, bf16x8 pa2, bf16x8 pa3) {
#define VOFF(ks, half) (D0 * 512 + (2 * (ks) + (half)) * NCB * 512)
    const s16x4 l0 = tr_read<VOFF(0, 0)>(vb), h0 = tr_read<VOFF(0, 1)>(vb), l1 = tr_read<VOFF(1, 0)>(vb), h1 = tr_read<VOFF(1, 1)>(vb);
    const s16x4 l2 = tr_read<VOFF(2, 0)>(vb), h2 = tr_read<VOFF(2, 1)>(vb), l3 = tr_read<VOFF(3, 0)>(vb), h3 = tr_read<VOFF(3, 1)>(vb);
#undef VOFF
    asm volatile("s_waitcnt lgkmcnt(0)" ::: "memory"); SBAR();
#define PK(L, H) (bf16x8){L[0], L[1], L[2], L[3], H[0], H[1], H[2], H[3]}
    od = MFMA32(pa0, PK(l0, h0), od); od = MFMA32(pa1, PK(l1, h1), od); od = MFMA32(pa2, PK(l2, h2), od); od = MFMA32(pa3, PK(l3, h3), od);
#undef PK
}
__device__ __forceinline__ float rowmax(const f32x16& p0, const f32x16& p1) {
    float a = MX3(p0[0], p0[1], p1[0]), b = MX3(p0[2], p0[3], p1[1]); a = MX3(a, p1[2], p1[3]);
#pragma unroll
    for (int r = 4; r < 16; r += 4) { a = MX3(a, p0[r], p0[r + 1]); b = MX3(b, p0[r + 2], p0[r + 3]); a = MX3(a, p1[r], p1[r + 1]); b = MX3(b, p1[r + 2], p1[r + 3]); }
    float rm = __builtin_fmaxf(a, b);
    auto rr = __builtin_amdgcn_permlane32_swap(__float_as_uint(rm), __float_as_uint(rm), false, false);
    return __builtin_fmaxf(__uint_as_float(rr[0]), __uint_as_float(rr[1]));
}

template <int DV, bool ALIBI, int LDQ, int LDK, int LDV>
__device__ __forceinline__ void attn_body(const bf16_t* __restrict__ Qw, const bf16_t* __restrict__ Kh, const bf16_t* __restrict__ Vh, int qw0, int t0, float cal,
                                          f32x16 (&o)[DV / 32], float& l_out, LAS char* lds) {
    constexpr int NCB = DV / 32;
    int tid = threadIdx.x; asm volatile("" : "+v"(tid));
    const int lane = tid & 63, r32 = lane & 31, hi = lane >> 5; const int wid = __builtin_amdgcn_readfirstlane(tid >> 6);
    LAS char* V_lds = lds + LDS_V; LAS char* K_lds = lds + LDS_K;
    LAS float* al_l = (LAS float*)(lds + LDS_WS) + wid * 64 + 32;
    float mhat = 0.f, l_reg = 0.f;
#pragma unroll
    for (int d = 0; d < NCB; ++d) o[d] = f32x16{};
    bf16x8 qr[4];
#pragma unroll
    for (int d0 = 0; d0 < 4; ++d0) qr[d0] = *(const bf16x8*)(Qw + (size_t)r32 * LDQ + d0 * 16 + hi * 8);
    const int kr = tid >> 3, kc = (tid & 7) * 8, kst = KSWZ64(kr, kc * 2);
    const int vr = (DV == 64) ? (tid >> 3) : (tid >> 4), vc = (DV == 64) ? (tid & 7) * 8 : (tid & 15) * 8;
    const int vst0 = v_st<NCB>(vr, vc), vst1 = v_st<NCB>(32 + vr, vc);
    const unsigned vb0 = (unsigned)(uintptr_t)V_lds + (unsigned)v_rd_base(lane);
    const bf16_t* kg = Kh + (size_t)kr * LDK + kc; const bf16_t* vg = Vh + (size_t)vr * LDV + vc;
    bf16x8 sk, sv0, sv1;
#define TILE(i) (((i) + t0) & (NT - 1))
#define SLOAD(tl) do { const size_t k0_ = (size_t)(tl) * KVBLK; sk = *(const bf16x8*)(kg + k0_ * LDK); sv0 = *(const bf16x8*)(vg + k0_ * LDV); \
        if (DV == 128) sv1 = *(const bf16x8*)(vg + (k0_ + 32) * LDV); } while (0)
#define SWRITE(b) do { *(LAS bf16x8*)(K_lds + (b) * SHM_K + kst) = sk; *(LAS bf16x8*)(V_lds + (b) * SHM_V + vst0) = sv0; \
        if (DV == 128) *(LAS bf16x8*)(V_lds + (b) * SHM_V + vst1) = sv1; } while (0)
    float ncal = -cal; asm volatile("" : "+v"(ncal));
    const int qpos = qw0 + r32; const float c32 = 32.f * cal;
#define COMPUTE(b, tl, FIRST) do { f32x16 p0, p1; \
        if (ALIBI) { const float cdq = cal * (float)(qpos - 4 * hi - (tl) * KVBLK), nm = -mhat, e1_ = cdq - c32; \
            _Pragma("unroll") for (int r = 0; r < 16; ++r) { const float kf_ = (float)((r & 3) + 8 * (r >> 2)); \
                p0[r] = nm - __builtin_fabsf(__builtin_fmaf(ncal, kf_, cdq)); p1[r] = nm - __builtin_fabsf(__builtin_fmaf(ncal, kf_, e1_)); } } \
        { const LAS char* Ks_ = K_lds + (b) * SHM_K; \
          _Pragma("unroll") for (int d0 = 0; d0 < 4; ++d0) { const int cb = (d0 * 16 + hi * 8) * 2; \
            const bf16x8 b0 = *(const LAS bf16x8*)(Ks_ + KSWZ64(r32, cb)), b1 = *(const LAS bf16x8*)(Ks_ + KSWZ64(32 + r32, cb)); \
            if (d0 == 0 && !ALIBI) { const f32x16 z = f32x16{}; p0 = MFMA32(b0, qr[0], z); p1 = MFMA32(b1, qr[0], z); } else { p0 = MFMA32(b0, qr[d0], p0); p1 = MFMA32(b1, qr[d0], p1); } } } \
        const float rm_ = rowmax(p0, p1) - (ALIBI ? 0.f : mhat); float alpha_ = 1.f; bool resc_ = false; \
        if ((FIRST) || __any(rm_ > THR)) { const float dl_ = (FIRST) ? rm_ : __builtin_fmaxf(rm_, 0.f); mhat += dl_; \
            if (!(FIRST)) { alpha_ = __builtin_amdgcn_exp2f(-dl_); resc_ = true; } } \
        SUBEXP(p0, p1); \
        float ps_ = 0.f; _Pragma("unroll") for (int r = 0; r < 16; ++r) ps_ += p0[r]; _Pragma("unroll") for (int r = 0; r < 16; ++r) ps_ += p1[r]; \
        l_reg = l_reg * alpha_ + ps_; \
        const v4u w0 = {cvtpk(p0[0], p0[1]), cvtpk(p0[2], p0[3]), cvtpk(p0[4], p0[5]), cvtpk(p0[6], p0[7])}, w1 = {cvtpk(p0[8], p0[9]), cvtpk(p0[10], p0[11]), cvtpk(p0[12], p0[13]), cvtpk(p0[14], p0[15])}; \
        const v4u w2 = {cvtpk(p1[0], p1[1]), cvtpk(p1[2], p1[3]), cvtpk(p1[4], p1[5]), cvtpk(p1[6], p1[7])}, w3 = {cvtpk(p1[8], p1[9]), cvtpk(p1[10], p1[11]), cvtpk(p1[12], p1[13]), cvtpk(p1[14], p1[15])}; \
        const bf16x8 pa0 = __builtin_bit_cast(bf16x8, w0), pa1 = __builtin_bit_cast(bf16x8, w1), pa2 = __builtin_bit_cast(bf16x8, w2), pa3 = __builtin_bit_cast(bf16x8, w3); \
        if (resc_) { if (hi == 0) al_l[r32] = alpha_; asm volatile("s_waitcnt lgkmcnt(0)" ::: "memory"); \
            _Pragma("unroll") for (int r = 0; r < 16; ++r) { const float f_ = al_l[crow(r, hi)]; _Pragma("unroll") for (int d = 0; d < NCB; ++d) o[d][r] *= f_; } } \
        const unsigned vb_ = vb0 + (b) * SHM_V; pv_one<NCB, 0>(o[0], vb_, pa0, pa1, pa2, pa3); pv_one<NCB, 1>(o[1], vb_, pa0, pa1, pa2, pa3); \
        if constexpr (NCB == 4) { pv_one<NCB, 2>(o[2], vb_, pa0, pa1, pa2, pa3); pv_one<NCB, 3>(o[3], vb_, pa0, pa1, pa2, pa3); } } while (0)
#define SUBEXP(P0, P1) do { const float s_ = ALIBI ? (mhat - mh_old_) : mhat; \
        _Pragma("unroll") for (int r = 0; r < 16; ++r) { P0[r] = __builtin_amdgcn_exp2f(P0[r] - s_); P1[r] = __builtin_amdgcn_exp2f(P1[r] - s_); } } while (0)
    float mh_old_ = 0.f;
    SLOAD(TILE(0)); asm volatile("s_waitcnt vmcnt(0)" ::: "memory"); SWRITE(0); SLOAD(TILE(1)); __syncthreads();
    for (int i = 0; i < NT; i += 2) {
        SWRITE(1); if (i + 2 < NT) SLOAD(TILE(i + 2));
        mh_old_ = mhat;
        COMPUTE(0, TILE(i), (i == 0));
        __syncthreads();
        if (i + 2 < NT) { SWRITE(0); if (i + 3 < NT) SLOAD(TILE(i + 3)); }
        mh_old_ = mhat;
        COMPUTE(1, TILE(i + 1), false);
        __syncthreads();
    }
    { auto rr = __builtin_amdgcn_permlane32_swap(__float_as_uint(l_reg), __float_as_uint(l_reg), false, false); l_out = __uint_as_float(rr[0]) + __uint_as_float(rr[1]); }
#undef TILE
#undef SLOAD
#undef SWRITE
#undef COMPUTE
#undef SUBEXP
}

template <int DV, bool ALIBI, int LDQ, int LDK, int LDV>
__device__ __forceinline__ void attn_fast(const bf16_t* __restrict__ Qw, const bf16_t* __restrict__ Kh, const bf16_t* __restrict__ Vh, int qw0, int tlo, int nt, float cal, float nref,
                                          f32x16 (&o)[DV / 32], float& l_out, LAS char* lds) {
    constexpr int NCB = DV / 32;
    int tid = threadIdx.x; asm volatile("" : "+v"(tid));
    const int lane = tid & 63, r32 = lane & 31, hi = lane >> 5;
    LAS char* V_lds = lds + LDS_V; LAS char* K_lds = lds + LDS_K;
    float l_reg = 0.f;
#pragma unroll
    for (int d = 0; d < NCB; ++d) o[d] = f32x16{};
    bf16x8 qr[4];
#pragma unroll
    for (int d0 = 0; d0 < 4; ++d0) qr[d0] = *(const bf16x8*)(Qw + (size_t)r32 * LDQ + d0 * 16 + hi * 8);
    const int kr = tid >> 3, kc = (tid & 7) * 8, kst = KSWZ64(kr, kc * 2);
    const int vr = (DV == 64) ? (tid >> 3) : (tid >> 4), vc = (DV == 64) ? (tid & 7) * 8 : (tid & 15) * 8;
    const int vst0 = v_st<NCB>(vr, vc), vst1 = v_st<NCB>(32 + vr, vc);
    const unsigned vb0 = (unsigned)(uintptr_t)V_lds + (unsigned)v_rd_base(lane);
    const bf16_t* kg = Kh + ((size_t)tlo * KVBLK + kr) * LDK + kc; const bf16_t* vg = Vh + ((size_t)tlo * KVBLK + vr) * LDV + vc;
    bf16x8 sk, sv0, sv1;
#define SLOAD(i_) do { const size_t k0_ = (size_t)(i_) * KVBLK; sk = *(const bf16x8*)(kg + k0_ * LDK); sv0 = *(const bf16x8*)(vg + k0_ * LDV); \
        if (DV == 128) sv1 = *(const bf16x8*)(vg + (k0_ + 32) * LDV); } while (0)
#define SWRITE(b) do { *(LAS bf16x8*)(K_lds + (b) * SHM_K + kst) = sk; *(LAS bf16x8*)(V_lds + (b) * SHM_V + vst0) = sv0; \
        if (DV == 128) *(LAS bf16x8*)(V_lds + (b) * SHM_V + vst1) = sv1; } while (0)
    float ncal = -cal; asm volatile("" : "+v"(ncal));
    const int qrel = qw0 + r32 - 4 * hi - tlo * KVBLK; const float c32 = 32.f * cal;
#define COMPUTE(b, i_) do { f32x16 p0, p1; \
        if (ALIBI) { const float cdq = cal * (float)(qrel - (i_) * KVBLK), e1_ = cdq - c32; \
            _Pragma("unroll") for (int r = 0; r < 16; ++r) { const float kf_ = (float)((r & 3) + 8 * (r >> 2)); \
                p0[r] = nref - __builtin_fabsf(__builtin_fmaf(ncal, kf_, cdq)); p1[r] = nref - __builtin_fabsf(__builtin_fmaf(ncal, kf_, e1_)); } } \
        { const LAS char* Ks_ = K_lds + (b) * SHM_K; \
          _Pragma("unroll") for (int d0 = 0; d0 < 4; ++d0) { const int cb = (d0 * 16 + hi * 8) * 2; \
            const bf16x8 b0 = *(const LAS bf16x8*)(Ks_ + KSWZ64(r32, cb)), b1 = *(const LAS bf16x8*)(Ks_ + KSWZ64(32 + r32, cb)); \
            if (d0 == 0 && !ALIBI) { const f32x16 z = f32x16{}; p0 = MFMA32(b0, qr[0], z); p1 = MFMA32(b1, qr[0], z); } else { p0 = MFMA32(b0, qr[d0], p0); p1 = MFMA32(b1, qr[d0], p1); } } } \
        _Pragma("unroll") for (int r = 0; r < 16; ++r) { p0[r] = __builtin_amdgcn_exp2f(p0[r]); p1[r] = __builtin_amdgcn_exp2f(p1[r]); } \
        float ps_ = 0.f; _Pragma("unroll") for (int r = 0; r < 16; ++r) ps_ += p0[r]; _Pragma("unroll") for (int r = 0; r < 16; ++r) ps_ += p1[r]; \
        l_reg += ps_; \
        const v4u w0 = {cvtpk(p0[0], p0[1]), cvtpk(p0[2], p0[3]), cvtpk(p0[4], p0[5]), cvtpk(p0[6], p0[7])}, w1 = {cvtpk(p0[8], p0[9]), cvtpk(p0[10], p0[11]), cvtpk(p0[12], p0[13]), cvtpk(p0[14], p0[15])}; \
        const v4u w2 = {cvtpk(p1[0], p1[1]), cvtpk(p1[2], p1[3]), cvtpk(p1[4], p1[5]), cvtpk(p1[6], p1[7])}, w3 = {cvtpk(p1[8], p1[9]), cvtpk(p1[10], p1[11]), cvtpk(p1[12], p1[13]), cvtpk(p1[14], p1[15])}; \
        const bf16x8 pa0 = __builtin_bit_cast(bf16x8, w0), pa1 = __builtin_bit_cast(bf16x8, w1), pa2 = __builtin_bit_cast(bf16x8, w2), pa3 = __builtin_bit_cast(bf16x8, w3); \
        const unsigned vb_ = vb0 + (b) * SHM_V; pv_one<NCB, 0>(o[0], vb_, pa0, pa1, pa2, pa3); pv_one<NCB, 1>(o[1], vb_, pa0, pa1, pa2, pa3); \
        if constexpr (NCB == 4) { pv_one<NCB, 2>(o[2], vb_, pa0, pa1, pa2, pa3); pv_one<NCB, 3>(o[3], vb_, pa0, pa1, pa2, pa3); } } while (0)
    SLOAD(0); asm volatile("s_waitcnt vmcnt(0)" ::: "memory"); SWRITE(0); SLOAD(1); __syncthreads();
    for (int i = 0; i < nt; i += 2) {
        SWRITE(1); if (i + 2 < nt) SLOAD(i + 2);
        COMPUTE(0, i);
        __syncthreads();
        if (i + 2 < nt) { SWRITE(0); if (i + 3 < nt) SLOAD(i + 3); }
        COMPUTE(1, i + 1);
        __syncthreads();
    }
    { auto rr = __builtin_amdgcn_permlane32_swap(__float_as_uint(l_reg), __float_as_uint(l_reg), false, false); l_out = __uint_as_float(rr[0]) + __uint_as_float(rr[1]); }
#undef SLOAD
#undef SWRITE
#undef COMPUTE
}

template <int DV, bool ALIBI, int LDQ, int LDK, int LDV>
__device__ __forceinline__ void attn_body_p(const bf16_t* __restrict__ Qw, const bf16_t* __restrict__ Kh, const bf16_t* __restrict__ Vh, int qw0, int t0, float cal,
                                            f32x16 (&o)[DV / 32], float& l_out, LAS char* lds) {
    constexpr int NCB = DV / 32, PLDS_K = 3 * SHM_V;
    int tid = threadIdx.x; asm volatile("" : "+v"(tid));
    const int lane = tid & 63, r32 = lane & 31, hi = lane >> 5; const int wid = __builtin_amdgcn_readfirstlane(tid >> 6);
    LAS char* V_lds = lds; LAS char* K_lds = lds + PLDS_K;
    LAS float* al_l = (LAS float*)(lds + LDS_WS) + wid * 64 + 32;
    float mhat = 0.f, l_reg = 0.f;
#pragma unroll
    for (int d = 0; d < NCB; ++d) o[d] = f32x16{};
    bf16x8 qr[4];
#pragma unroll
    for (int d0 = 0; d0 < 4; ++d0) qr[d0] = *(const bf16x8*)(Qw + (size_t)r32 * LDQ + d0 * 16 + hi * 8);
    const int kr = tid >> 3, kc = (tid & 7) * 8, kst = KSWZ64(kr, kc * 2);
    const int vr = (DV == 64) ? (tid >> 3) : (tid >> 4), vc = (DV == 64) ? (tid & 7) * 8 : (tid & 15) * 8;
    const int vst0 = v_st<NCB>(vr, vc), vst1 = v_st<NCB>(32 + vr, vc);
    const unsigned vb0 = (unsigned)(uintptr_t)V_lds + (unsigned)v_rd_base(lane);
    const bf16_t* kg = Kh + (size_t)kr * LDK + kc; const bf16_t* vg = Vh + (size_t)vr * LDV + vc;
    bf16x8 sk, sv0, sv1;
#define TILE(i) (((i) + t0) & (NT - 1))
#define SLOAD(tl) do { const size_t k0_ = (size_t)(tl) * KVBLK; sk = *(const bf16x8*)(kg + k0_ * LDK); sv0 = *(const bf16x8*)(vg + k0_ * LDV); \
        if (DV == 128) sv1 = *(const bf16x8*)(vg + (k0_ + 32) * LDV); } while (0)
#define SWRITE(kb, voff) do { *(LAS bf16x8*)(K_lds + (kb) * SHM_K + kst) = sk; *(LAS bf16x8*)(V_lds + (voff) + vst0) = sv0; \
        if (DV == 128) *(LAS bf16x8*)(V_lds + (voff) + vst1) = sv1; } while (0)
    float ncal = -cal; asm volatile("" : "+v"(ncal));
    const int qpos = qw0 + r32; const float c32 = 32.f * cal;
#define INITC(P0, P1, tl) do { if (ALIBI) { const float cdq = cal * (float)(qpos - 4 * hi - (tl) * KVBLK), nm = -mhat, e1_ = cdq - c32; \
        _Pragma("unroll") for (int r = 0; r < 16; ++r) { const float kf_ = (float)((r & 3) + 8 * (r >> 2)); \
            P0[r] = nm - __builtin_fabsf(__builtin_fmaf(ncal, kf_, cdq)); P1[r] = nm - __builtin_fabsf(__builtin_fmaf(ncal, kf_, e1_)); } } } while (0)
#define QKT(P0, P1, kb) do { const LAS char* Ks_ = K_lds + (kb) * SHM_K; \
        _Pragma("unroll") for (int d0 = 0; d0 < 4; ++d0) { const int cb = (d0 * 16 + hi * 8) * 2; \
            const bf16x8 b0 = *(const LAS bf16x8*)(Ks_ + KSWZ64(r32, cb)), b1 = *(const LAS bf16x8*)(Ks_ + KSWZ64(32 + r32, cb)); \
            if (d0 == 0 && !ALIBI) { const f32x16 z = f32x16{}; P0 = MFMA32(b0, qr[0], z); P1 = MFMA32(b1, qr[0], z); } else { P0 = MFMA32(b0, qr[d0], P0); P1 = MFMA32(b1, qr[d0], P1); } } } while (0)
#define PARTIAL(P0, P1, FIRST, SUB, ALPHA, RESCF) do { const float rm_ = rowmax(P0, P1) - (ALIBI ? 0.f : mhat); ALPHA = 1.f; RESCF = false; float dl_ = 0.f; \
        if ((FIRST) || __any(rm_ > THR)) { dl_ = (FIRST) ? rm_ : __builtin_fmaxf(rm_, 0.f); mhat += dl_; if (!(FIRST)) { ALPHA = __builtin_amdgcn_exp2f(-dl_); RESCF = true; } } \
        SUB = ALIBI ? dl_ : mhat; \
        _Pragma("unroll") for (int r = 0; r < 16; ++r) P0[r] = __builtin_amdgcn_exp2f(P0[r] - SUB); } while (0)
#define FINISH(P0, P1, SUB, ALPHA) do { _Pragma("unroll") for (int r = 0; r < 16; ++r) P1[r] = __builtin_amdgcn_exp2f(P1[r] - SUB); \
        float ps_ = 0.f; _Pragma("unroll") for (int r = 0; r < 16; ++r) ps_ += P0[r]; _Pragma("unroll") for (int r = 0; r < 16; ++r) ps_ += P1[r]; \
        l_reg = l_reg * (ALPHA) + ps_; \
        { const v4u w0 = {cvtpk(P0[0], P0[1]), cvtpk(P0[2], P0[3]), cvtpk(P0[4], P0[5]), cvtpk(P0[6], P0[7])}, w1 = {cvtpk(P0[8], P0[9]), cvtpk(P0[10], P0[11]), cvtpk(P0[12], P0[13]), cvtpk(P0[14], P0[15])}; \
          const v4u w2 = {cvtpk(P1[0], P1[1]), cvtpk(P1[2], P1[3]), cvtpk(P1[4], P1[5]), cvtpk(P1[6], P1[7])}, w3 = {cvtpk(P1[8], P1[9]), cvtpk(P1[10], P1[11]), cvtpk(P1[12], P1[13]), cvtpk(P1[14], P1[15])}; \
          pa0 = __builtin_bit_cast(bf16x8, w0); pa1 = __builtin_bit_cast(bf16x8, w1); pa2 = __builtin_bit_cast(bf16x8, w2); pa3 = __builtin_bit_cast(bf16x8, w3); } } while (0)
#define PVX(voff) do { const unsigned vb_ = vb0 + (unsigned)(voff); pv_one<NCB, 0>(o[0], vb_, pa0, pa1, pa2, pa3); pv_one<NCB, 1>(o[1], vb_, pa0, pa1, pa2, pa3); \
        if constexpr (NCB == 4) { pv_one<NCB, 2>(o[2], vb_, pa0, pa1, pa2, pa3); pv_one<NCB, 3>(o[3], vb_, pa0, pa1, pa2, pa3); } } while (0)
#define RESC(ALPHA, RESCF) do { if (RESCF) { if (hi == 0) al_l[r32] = (ALPHA); asm volatile("s_waitcnt lgkmcnt(0)" ::: "memory"); \
        _Pragma("unroll") for (int r = 0; r < 16; ++r) { const float f_ = al_l[crow(r, hi)]; _Pragma("unroll") for (int d = 0; d < NCB; ++d) o[d][r] *= f_; } } } while (0)
#define ROT() do { const int t_ = vprev; vprev = vcur; vcur = vnext; vnext = t_; } while (0)
    f32x16 pA0 = f32x16{}, pA1 = f32x16{}, pB0 = f32x16{}, pB1 = f32x16{}; float subA, subB, alA, alB; bool rsA, rsB; bf16x8 pa0, pa1, pa2, pa3;
    int vprev = 0, vcur = SHM_V, vnext = 2 * SHM_V;
    SLOAD(TILE(0)); asm volatile("s_waitcnt vmcnt(0)" ::: "memory"); SWRITE(0, 0); SLOAD(TILE(1)); __syncthreads();
    SWRITE(1, SHM_V); SLOAD(TILE(2));
    INITC(pA0, pA1, TILE(0)); QKT(pA0, pA1, 0); PARTIAL(pA0, pA1, true, subA, alA, rsA);
    __syncthreads();
    for (int j = 1; j < NT; j += 2) {
        if (j + 1 < NT) { SWRITE(0, vnext); if (j + 2 < NT) SLOAD(TILE(j + 2)); }
        SBAR(); INITC(pB0, pB1, TILE(j)); QKT(pB0, pB1, 1);
        FINISH(pA0, pA1, subA, alA); SBAR();
        PVX(vprev); PARTIAL(pB0, pB1, false, subB, alB, rsB); RESC(alB, rsB);
        __syncthreads(); ROT();
        if (j + 1 >= NT) break;
        if (j + 2 < NT) { SWRITE(1, vnext); if (j + 3 < NT) SLOAD(TILE(j + 3)); }
        SBAR(); INITC(pA0, pA1, TILE(j + 1)); QKT(pA0, pA1, 0);
        FINISH(pB0, pB1, subB, alB); SBAR();
        PVX(vprev); PARTIAL(pA0, pA1, false, subA, alA, rsA); RESC(alA, rsA);
        __syncthreads(); ROT();
    }
    FINISH(pB0, pB1, subB, alB); SBAR();
    PVX(vprev);
    { auto rr = __builtin_amdgcn_permlane32_swap(__float_as_uint(l_reg), __float_as_uint(l_reg), false, false); l_out = __uint_as_float(rr[0]) + __uint_as_float(rr[1]); }
    __syncthreads();
#undef TILE
#undef SLOAD
#undef SWRITE
#undef INITC
#undef QKT
#undef PARTIAL
#undef FINISH
#undef PVX
#undef RESC
#undef ROT
}

template <int NCB> __device__ __forceinline__ void stage_o(const f32x16 (&o)[NCB], float l, LAS float* stg, LAS float* li_l, int r32, int hi) {
#pragma unroll
    for (int d = 0; d < NCB; ++d)
#pragma unroll
        for (int r = 0; r < 16; ++r) stg[crow(r, hi) * (NCB * 32) + d * 32 + r32] = o[d][r];
    if (hi == 0) li_l[r32] = l;
    asm volatile("s_waitcnt lgkmcnt(0)" ::: "memory");
}
__device__ __forceinline__ v4u pack8(f32x4 a, f32x4 b) { v4u w = {cvtpk(a[0], a[1]), cvtpk(a[2], a[3]), cvtpk(b[0], b[1]), cvtpk(b[2], b[3])}; return w; }
__device__ __forceinline__ void unpack8(v4u g, f32x4& a, f32x4& b) {
    a = (f32x4){__uint_as_float(g.x << 16), __uint_as_float(g.x & 0xffff0000u), __uint_as_float(g.y << 16), __uint_as_float(g.y & 0xffff0000u)};
    b = (f32x4){__uint_as_float(g.z << 16), __uint_as_float(g.z & 0xffff0000u), __uint_as_float(g.w << 16), __uint_as_float(g.w & 0xffff0000u)}; }

__device__ __forceinline__ void unit_A(int b, int h, int qb, const bf16_t* QA, const bf16_t* KA, const bf16_t* VA, const bf16_t* GA, bf16_t* Y, const float* subw, const float* lq1, const float* lk1, const float* lq2, const float* lk2,
                                       const unsigned* kmaxtab, float* scr, LAS char* lds) {
    const float cal = __builtin_ldexpf(1.f, -2 * (h + 1)) * LOG2E;
#pragma nounroll
    for (int mp = 0; mp < 2; ++mp) {
        f32x16 o[4]; float l;
        { int tid1 = threadIdx.x; asm volatile("" : "+v"(tid1));
          const int lane1 = tid1 & 63, wid = __builtin_amdgcn_readfirstlane(tid1 >> 6); const size_t row0 = (size_t)b * SEQ + qb * 256 + wid * 32;
          const bf16_t* Qw = QA + row0 * 512 + h * 128 + mp * 64; const bf16_t* Kh = KA + (size_t)b * SEQ * 512 + h * 128 + mp * 64; const bf16_t* Vh = VA + (size_t)b * SEQ * 512 + h * 128;
          float q2 = 0.f;
#pragma unroll
          for (int d0 = 0; d0 < 4; ++d0) { const bf16x8 v = *(const bf16x8*)(Qw + (size_t)(lane1 & 31) * 512 + d0 * 16 + (lane1 >> 5) * 8);
#pragma unroll
              for (int e = 0; e < 8; ++e) { const float f = bf2f((bf16_t)v[e]); q2 += f * f; } }
          q2 += __shfl_xor(q2, 32);
          float qm = q2;
#pragma unroll
          for (int sh = 1; sh < 32; sh <<= 1) qm = __builtin_fmaxf(qm, __shfl_xor(qm, sh));
          LAS float* qmx = (LAS float*)(lds + LDS_WS + 2048);
          if (lane1 == 0) qmx[wid] = qm;
          __syncthreads();
          float Qmax2 = qmx[0];
#pragma unroll
          for (int w = 1; w < 8; ++w) Qmax2 = __builtin_fmaxf(Qmax2, qmx[w]);
          const float kmax2 = __uint_as_float(__hip_atomic_load(kmaxtab + (b * 4 + h) * 2 + mp, __ATOMIC_RELAXED, __HIP_MEMORY_SCOPE_AGENT)) * 1.0001f;
          const float QK = __builtin_sqrtf(Qmax2 * kmax2);
          if (QK <= 50.f) {
              const int R = (int)((2.f * QK + 80.f) / cal) + 1, q0 = qb * 256;
              int tlo = (q0 - R) >> 6; if (tlo < 0) tlo = 0; int thi = (q0 + 255 + R) >> 6; if (thi > NT - 1) thi = NT - 1;
              if (((thi - tlo + 1) & 1) != 0) { if (thi < NT - 1) ++thi; else --tlo; }
              attn_fast<128, true, 512, 512, 512>(Qw, Kh, Vh, qb * 256 + wid * 32, tlo, thi - tlo + 1, cal, -__builtin_sqrtf(q2 * kmax2), o, l, lds);
          } else
              ATT_BODY_A<128, true, 512, 512, 512>(Qw, Kh, Vh, qb * 256 + wid * 32, qb * 4, cal, o, l, lds); }
        int tid2 = threadIdx.x; asm volatile("" : "+v"(tid2));
        const int lane = tid2 & 63, wid = __builtin_amdgcn_readfirstlane(tid2 >> 6), rsub = lane >> 4, c8 = (lane & 15) * 8;
        LAS float* stg = (LAS float*)(lds + wid * 16384); LAS float* li_l = (LAS float*)(lds + LDS_WS) + wid * 64;
        float* scrw = scr + wid * 4096; const size_t row0 = (size_t)b * SEQ + qb * 256 + wid * 32;
        stage_o<4>(o, l, stg, li_l, lane & 31, lane >> 5);
        if (mp == 0) {
#pragma unroll 2
            for (int it = 0; it < 8; ++it) { const int row = it * 4 + rsub; const float rl = __builtin_amdgcn_rcpf(li_l[row]);
                const f32x4 v0 = *(const LAS f32x4*)(stg + row * 128 + c8) * rl, v1 = *(const LAS f32x4*)(stg + row * 128 + c8 + 4) * rl;
                *(f32x4*)(scrw + row * 128 + c8) = v0; *(f32x4*)(scrw + row * 128 + c8 + 4) = v1; }
        } else {
            const f32x4 w0 = *(const f32x4*)(subw + c8), w1 = *(const f32x4*)(subw + c8 + 4);
            const float lam = expf(wave_sum(lq1[lane] * lk1[lane])) - expf(wave_sum(lq2[lane] * lk2[lane])) + LAM_INIT;
#pragma unroll 2
            for (int it = 0; it < 8; ++it) { const int row = it * 4 + rsub; const float rl = __builtin_amdgcn_rcpf(li_l[row]);
                const f32x4 v0 = *(const LAS f32x4*)(stg + row * 128 + c8) * rl, v1 = *(const LAS f32x4*)(stg + row * 128 + c8 + 4) * rl;
                const f32x4 d0 = *(const f32x4*)(scrw + row * 128 + c8) - lam * v0, d1 = *(const f32x4*)(scrw + row * 128 + c8 + 4) - lam * v1;
                float ss = (d0[0] * d0[0] + d0[1] * d0[1]) + (d0[2] * d0[2] + d0[3] * d0[3]) + (d1[0] * d1[0] + d1[1] * d1[1]) + (d1[2] * d1[2] + d1[3] * d1[3]);
                ss += __shfl_xor(ss, 1); ss += __shfl_xor(ss, 2); ss += __shfl_xor(ss, 4); ss += __shfl_xor(ss, 8);
                const float rs = __builtin_amdgcn_rsqf(ss * (1.f / 128.f) + NORM_EPS) * (1.f - LAM_INIT);
                f32x4 g0, g1; unpack8(*(const v4u*)(GA + (row0 + row) * 512 + h * 128 + c8), g0, g1);
                *(v4u*)(Y + (row0 + row) * 1024 + h * 128 + c8) = pack8(d0 * rs * w0 * g0, d1 * rs * w1 * g1); }
        }
        __syncthreads();
    }
}
__device__ __forceinline__ void unit_B(int b, int head, int qb, bool bfast, const bf16_t* QB, const bf16_t* KB, const bf16_t* VB, const bf16_t* GB, bf16_t* Y, LAS char* lds) {
    f32x16 o[2]; float l;
    { const int wid = __builtin_amdgcn_readfirstlane(threadIdx.x >> 6); const size_t row0 = (size_t)b * SEQ + qb * 256 + wid * 32; const int kvh = head >> 2;
      if (bfast) attn_fast<64, false, 512, 128, 128>(QB + row0 * 512 + head * 64, KB + (size_t)b * SEQ * 128 + kvh * 64, VB + (size_t)b * SEQ * 128 + kvh * 64, qb * 256 + wid * 32, 0, NT, 0.f, 0.f, o, l, lds);
      else ATT_BODY_B<64, false, 512, 128, 128>(QB + row0 * 512 + head * 64, KB + (size_t)b * SEQ * 128 + kvh * 64, VB + (size_t)b * SEQ * 128 + kvh * 64, qb * 256 + wid * 32, 0, 0.f, o, l, lds); }
    int tid2 = threadIdx.x; asm volatile("" : "+v"(tid2));
    const int lane = tid2 & 63, wid = __builtin_amdgcn_readfirstlane(tid2 >> 6), rsub = lane >> 3, c8 = (lane & 7) * 8;
    LAS float* stg = (LAS float*)(lds + wid * 16384); LAS float* li_l = (LAS float*)(lds + LDS_WS) + wid * 64; const size_t row0 = (size_t)b * SEQ + qb * 256 + wid * 32;
    stage_o<2>(o, l, stg, li_l, lane & 31, lane >> 5);
#pragma unroll 2
    for (int it = 0; it < 4; ++it) { const int row = it * 8 + rsub; const float rl = __builtin_amdgcn_rcpf(li_l[row]);
        const f32x4 v0 = *(const LAS f32x4*)(stg + row * 64 + c8) * rl, v1 = *(const LAS f32x4*)(stg + row * 64 + c8 + 4) * rl;
        f32x4 g0, g1; unpack8(*(const v4u*)(GB + (row0 + row) * 512 + head * 64 + c8), g0, g1);
        *(v4u*)(Y + (row0 + row) * 1024 + 512 + head * 64 + c8) = pack8(v0 * g0, v1 * g1); }
    __syncthreads();
}
#undef SBAR
}

#define XB_TMO      128
#define XB_XCNT(j)  (256  + 64 * (j))
#define XB_XSUB(j)  (1280 + 64 * (j))
#define XB_XGEN(j)  (2304 + 64 * (j))
#define XB_TOP      3328
#define XB_TOPGEN   3392
#define XCD_BAR_WORDS 3456
#define XB_SPIN_CAP (1u << 18)

__device__ __forceinline__ unsigned xb_ld(unsigned* p)              { return __hip_atomic_load(p, __ATOMIC_RELAXED, __HIP_MEMORY_SCOPE_AGENT); }
__device__ __forceinline__ unsigned xb_add(unsigned* p, unsigned v) { return __hip_atomic_fetch_add(p, v, __ATOMIC_RELAXED, __HIP_MEMORY_SCOPE_AGENT); }
__device__ __forceinline__ unsigned xb_xcc_id() { return (unsigned)__builtin_amdgcn_s_getreg((3 << 11) | 20) & 0xFu; }
#define XB_SPIN(cond, bar) do { unsigned _sp = 0; while (cond) { __builtin_amdgcn_s_sleep(1); \
    if ((++_sp & 255u) == 0u) { if (xb_ld(&(bar)[XB_TMO])) break; if (_sp > XB_SPIN_CAP) { atomicAdd(&(bar)[XB_TMO], 1u); break; } } } } while (0)

struct XcdBarrier {
    unsigned* bar; unsigned x;
    volatile LAS unsigned* st;
};

__device__ __forceinline__ XcdBarrier xcd_barrier_post(unsigned* bar, volatile LAS unsigned* st) {
    XcdBarrier b; b.bar = bar; b.x = xb_xcc_id(); b.st = st;
    if (threadIdx.x == 0) (void)xb_add(&bar[XB_XCNT(b.x)], 1u);
    return b;
}
__device__ __forceinline__ void xcd_barrier_complete(unsigned* bar, unsigned x, unsigned& nloc, unsigned& nx) {
    const unsigned G = gridDim.x * gridDim.y * gridDim.z;
    unsigned sum, cnt, mine, sp = 0u;
    for (;;) {
        sum = 0u; cnt = 0u; mine = 0u;
#pragma unroll
        for (unsigned j = 0; j < 16; ++j) { const unsigned c = xb_ld(&bar[XB_XCNT(j)]); sum += c; cnt += (c > 0u) ? 1u : 0u; mine = (j == x) ? c : mine; }
        if (sum == G) break;
        __builtin_amdgcn_s_sleep(1);
        if ((++sp & 255u) == 0u) { if (xb_ld(&bar[XB_TMO])) break; if (sp > XB_SPIN_CAP) { atomicAdd(&bar[XB_TMO], 1u); break; } }
    }
    nloc = mine > 0u ? mine : 1u; nx = cnt > 0u ? cnt : 1u;
}

__device__ __forceinline__ void xcd_barrier(const XcdBarrier& b) {
    asm volatile("s_waitcnt vmcnt(0)" ::: "memory");
    __syncthreads();
    if (threadIdx.x == 0) {
        unsigned* bar = b.bar;
        __builtin_amdgcn_s_waitcnt(0);
        unsigned nloc = b.st[0], nx = b.st[1];
        if (nloc == 0u) { xcd_barrier_complete(bar, b.x, nloc, nx); b.st[0] = nloc; b.st[1] = nx; }
        const unsigned old = xb_add(&bar[XB_XSUB(b.x)], 1u);
        const unsigned gen = old / nloc;
        if (old + 1u == (gen + 1u) * nloc) {
            __builtin_amdgcn_fence(__ATOMIC_RELEASE, "agent");
            asm volatile("s_waitcnt vmcnt(0)" ::: "memory");
            const unsigned og = xb_add(&bar[XB_TOP], 1u);
            const unsigned tg = og / nx;
            if (og + 1u == (tg + 1u) * nx) xb_add(&bar[XB_TOPGEN], 1u);
            else XB_SPIN(xb_ld(&bar[XB_TOPGEN]) == tg, bar);
            __builtin_amdgcn_fence(__ATOMIC_ACQUIRE, "agent");
            xb_add(&bar[XB_XGEN(b.x)], 1u);
            asm volatile("s_waitcnt vmcnt(0)" ::: "memory");
        } else {
            XB_SPIN(xb_ld(&bar[XB_XGEN(b.x)]) == gen, bar);
            __builtin_amdgcn_fence(__ATOMIC_ACQUIRE, "agent");
            asm volatile("s_waitcnt vmcnt(0)" ::: "memory");
        }
    }
    __syncthreads();
}

constexpr size_t MiB = 1u << 20;
constexpr size_t WS_CTL = 0, CTL_ZERO_BYTES = 64 * 1024;
constexpr size_t WS_MODP = 1 * MiB;
constexpr size_t WS_MODF = 2 * MiB;
constexpr size_t WS_TAB = 2 * MiB + 64 * 1024;
constexpr size_t WS_WIN = 4 * MiB, WS_WOUT = 12 * MiB;
constexpr size_t WS_H = 16 * MiB;
constexpr size_t WS_QA = 48 * MiB, WS_KA = 64 * MiB, WS_VA = 80 * MiB, WS_GA = 96 * MiB;
constexpr size_t WS_QB = 112 * MiB, WS_KB = 128 * MiB, WS_VB = 132 * MiB, WS_GB = 136 * MiB;
constexpr size_t WS_QBR = 152 * MiB, WS_KBR = 184 * MiB;
constexpr size_t WS_O0 = 192 * MiB;
constexpr size_t WS_END = 224 * MiB;

constexpr int NWAVES = 8, LDS_BYTES = 147456;
constexpr int LDS_CTL = 147456 - 256;
constexpr int CW_QUEUE = 8320;
constexpr int CW_KMAX = 8192;
constexpr int CW_BAR = 4096;
constexpr int LDS_MISC = 131072;

struct Args { const float *x, *c, *w_ada, *b_ada, *norm_w, *w_in, *lq1, *lk1, *lq2, *lk2, *subln_w, *qn_w, *kn_w, *w_out, *fn_w; float* out; unsigned char* ws; int ph_lo, ph_hi; };

__device__ __forceinline__ void transpose_item(const float* W, int K, int N, bf16_t* WT, LAS float* scr, int item, int lane) {
    const int nblk = N / 32, kb = item / nblk, nb = item % nblk, k0 = 64 * kb, n0 = 32 * nb;
#pragma unroll 8
    for (int i = 0; i < 32; ++i) { const int kk = 2 * i + (lane >> 5); scr[kk * 33 + (lane & 31)] = W[(size_t)(k0 + kk) * N + n0 + (lane & 31)]; }
    asm volatile("s_waitcnt lgkmcnt(0)" ::: "memory");
    const int c = lane & 7;
#pragma unroll
    for (int j = 0; j < 4; ++j) { const int n = (lane >> 3) + 8 * j; const LAS float* s = scr + (8 * c) * 33 + n;
        v4u o; o.x = cvtpk(s[0 * 33], s[1 * 33]); o.y = cvtpk(s[2 * 33], s[3 * 33]); o.z = cvtpk(s[4 * 33], s[5 * 33]); o.w = cvtpk(s[6 * 33], s[7 * 33]);
        *(v4u*)(WT + (size_t)(n0 + n) * K + k0 + 8 * c) = o; }
    asm volatile("s_waitcnt lgkmcnt(0)" ::: "memory");
}

__global__ void __launch_bounds__(NWAVES * 64, 2) mega(Args a) {
    extern __shared__ __attribute__((aligned(16))) unsigned char lds_raw[];
    LAS unsigned char* lds = (LAS unsigned char*)lds_raw;
    const int tid = threadIdx.x, lane = tid & 63; const int wid = __builtin_amdgcn_readfirstlane(tid >> 6);
    const int G = gridDim.x, bx = blockIdx.x, vcu = (G % 8 == 0) ? (bx % 8) * (G / 8) + bx / 8 : bx;
    const int gw = vcu * NWAVES + wid, NGW = G * NWAVES;
    unsigned char* ws = a.ws;
#define WS_PTRS() unsigned char* wsp_ = a.ws; asm volatile("" : "+s"(wsp_)); __attribute__((address_space(1))) unsigned char* wsp = (__attribute__((address_space(1))) unsigned char*)wsp_; \
    float* modp = (float*)(wsp + WS_MODP); float* modf = (float*)(wsp + WS_MODF); f32x2* tab = (f32x2*)(wsp + WS_TAB); \
    bf16_t* WIN = (bf16_t*)(wsp + WS_WIN); bf16_t* WOUT = (bf16_t*)(wsp + WS_WOUT); bf16_t* H = (bf16_t*)(wsp + WS_H); bf16_t* Y = H; \
    bf16_t *QA = (bf16_t*)(wsp + WS_QA), *KA = (bf16_t*)(wsp + WS_KA), *VA = (bf16_t*)(wsp + WS_VA), *GA = (bf16_t*)(wsp + WS_GA); \
    bf16_t *QB = (bf16_t*)(wsp + WS_QB), *KB = (bf16_t*)(wsp + WS_KB), *VB = (bf16_t*)(wsp + WS_VB), *GB = (bf16_t*)(wsp + WS_GB); \
    float *QBR = (float*)(wsp + WS_QBR), *KBR = (float*)(wsp + WS_KBR); \
    (void)modp; (void)modf; (void)tab; (void)WIN; (void)WOUT; (void)H; (void)Y; (void)QA; (void)KA; (void)VA; (void)GA; (void)QB; (void)KB; (void)VB; (void)GB; (void)QBR; (void)KBR
    const int lo = a.ph_lo, hi_ = a.ph_hi;
    volatile LAS unsigned* MISC = (volatile LAS unsigned*)(lds + LDS_CTL);
    if (tid < 2) MISC[tid] = 0u;
    __syncthreads();
    XcdBarrier bar = xcd_barrier_post((unsigned*)(ws + WS_CTL) + CW_BAR, MISC);
#ifndef PH_MASK
#define PH_MASK 0x7f
#endif
#define IN(k) (((PH_MASK >> (k)) & 1) && lo <= (k) && (k) < hi_)
#define SEAM(k) do { if (IN(k) && IN((k) + 1)) xcd_barrier(bar); } while (0)

    if (IN(0)) { WS_PTRS();
        for (int it = gw; it < 384; it += NGW) {
            const int s = it / 12, col = (it % 12) * 256 + lane * 4;
            f32x4 a0 = {0.f, 0.f, 0.f, 0.f}, a1 = a0;
#pragma unroll 8
            for (int k = s * 32; k < s * 32 + 32; ++k) { const f32x4 w = *(const f32x4*)(a.w_ada + (size_t)k * 3072 + col);
                const float c0 = a.c[k], c1 = a.c[1024 + k]; a0 += pg8::silu_f(c0) * w; a1 += pg8::silu_f(c1) * w; }
            *(f32x4*)(modp + (size_t)(s * 2 + 0) * 3072 + col) = a0; *(f32x4*)(modp + (size_t)(s * 2 + 1) * 3072 + col) = a1;
        }
        { const int g = vcu * 512 + tid;
          if (g < 3072) { const int p = g >> 4, i = g & 15; const float freq = 1.0f / powf(10000.0f, (float)i * 2.0f / 32.0f);
              const float ang = (float)(p < 128 ? p : p - 128) * freq; float sn, cs; sincosf(ang, &sn, &cs); tab[g] = (f32x2){cs, sn}; } }
        LAS float* scr = (LAS float*)(lds + wid * 16384);
        constexpr int I_IN = (DM / 64) * (NPROJ / 32), I_OUT = (DM / 64) * (DM / 32);
        for (int it = gw; it < I_IN + I_OUT; it += NGW) {
            if (it < I_IN) transpose_item(a.w_in, DM, NPROJ, WIN, scr, it, lane); else transpose_item(a.w_out, DM, DM, WOUT, scr, it - I_IN, lane);
        }
    }
    SEAM(0);
    if (IN(1)) { WS_PTRS();
        LAS float* gsh = (LAS float*)(lds + LDS_MISC);
        for (int chunk = bx; chunk < 256; chunk += G) {
            const int b = chunk >> 7;
            for (int j = tid; j < 2048; j += 512) { const int col = j & 1023, midx = (j < 1024) ? 1024 + col : col;
                float v = a.b_ada[midx];
#pragma unroll 8
                for (int s = 0; s < 32; ++s) v += modp[(size_t)(s * 2 + b) * 3072 + midx];
                gsh[j] = (j < 1024) ? a.norm_w[col] * (1.f + v) : v; }
            if (chunk < 12) { const int j = chunk * 512 + tid, bb = j / 3072, idx = j % 3072; float v = a.b_ada[idx];
#pragma unroll 8
                for (int s = 0; s < 32; ++s) v += modp[(size_t)(s * 2 + bb) * 3072 + idx];
                modf[j] = v; }
            __syncthreads();
            for (int i = 0; i < 8; ++i) { const size_t row = (size_t)chunk * 64 + wid * 8 + i;
                const f32x4* xr = (const f32x4*)(a.x + row * DM) + lane; f32x4 v[4]; float s = 0.f;
#pragma unroll
                for (int j = 0; j < 4; ++j) { v[j] = xr[64 * j]; s += (v[j].x * v[j].x + v[j].y * v[j].y) + (v[j].z * v[j].z + v[j].w * v[j].w); }
                const float rstd = __builtin_amdgcn_rsqf(wave_sum(s) * (1.f / DM) + NORM_EPS);
                unsigned long long* o8 = (unsigned long long*)(H + row * DM) + lane;
#pragma unroll
                for (int j = 0; j < 4; ++j) { const int c0 = 4 * lane + 256 * j; const f32x4 g = *(const LAS f32x4*)(gsh + c0), sh = *(const LAS f32x4*)(gsh + 1024 + c0);
                    const f32x4 hv = v[j] * rstd * g + sh; o8[64 * j] = (unsigned long long)cvtpk(hv.x, hv.y) | ((unsigned long long)cvtpk(hv.z, hv.w) << 32); } }
            __syncthreads();
        }
    }
    SEAM(1);
    if (IN(2)) { WS_PTRS();
        pg8::Gemm g{H, WIN, M, NPROJ, DM}; pg8::StaticOrder S; S.init(M, NPROJ, G, bx);
        pg8::EpiProj E{QA, KA, VA, GA, VB, GB, QBR, KBR, C2};
#ifdef DUP_P2
        for (int rep_ = 0; rep_ < 2; ++rep_)
#endif
        pg8::gemm_phase<pg8::EpiProj, pg8::StaticOrder, true, true>(lds, g, S, E);
    }
    SEAM(2);
    if (IN(3)) { WS_PTRS();
        float kmx = 0.f;
        for (int it = gw; it < M * 18; it += NGW) { const int row = it / 18, hh = it % 18;
            if (hh >= 10) { const float kv = bf2f(KA[(size_t)row * 512 + (hh - 10) * 64 + lane]); const float n2 = wave_sum(kv * kv);
                if (lane == (row >> 13) * 8 + (hh - 10)) kmx = __builtin_fmaxf(kmx, n2); continue; }
            const float raw = hh < 8 ? QBR[(size_t)row * 512 + hh * 64 + lane] : KBR[(size_t)row * 128 + (hh - 8) * 64 + lane];
            const float rstd = __builtin_amdgcn_rsqf(wave_sum(raw * raw) * (1.f / 64.f) + NORM_EPS);
            const float y = raw * rstd * (hh < 8 ? a.qn_w[lane] : a.kn_w[lane]);
            const int t = row & (SEQ - 1), pos = lane < 32 ? (t >> 6) : 128 + (t & 63);
            const f32x2 cs = tab[pos * 16 + (lane & 15)]; const float pr = __shfl_xor(y, 16);
            const float ov = (lane & 16) ? y * cs.x + pr * cs.y : y * cs.x - pr * cs.y;
            if (hh < 8) QB[(size_t)row * 512 + hh * 64 + lane] = f2bf(ov * C2); else KB[(size_t)row * 128 + (hh - 8) * 64 + lane] = f2bf(ov); }
        if (lane < 16) atomicMax((unsigned*)(wsp_ + WS_CTL) + CW_KMAX + lane, __float_as_uint(kmx));
    }
    SEAM(3);
    if (IN(4)) { WS_PTRS();
        float* scr = (float*)(wsp + WS_O0) + (size_t)bx * 32768;
        float wq = __builtin_fabsf(a.qn_w[lane]), wk = __builtin_fabsf(a.kn_w[lane]);
#pragma unroll
        for (int sh = 1; sh < 64; sh <<= 1) { wq = __builtin_fmaxf(wq, __shfl_xor(wq, sh)); wk = __builtin_fmaxf(wk, __shfl_xor(wk, sh)); }
        const bool bfast = __builtin_amdgcn_readfirstlane((int)(64.f * C2 * 1.02f * wq * wk <= 40.f)) != 0;
        unsigned* qctr = (unsigned*)(wsp_ + WS_CTL) + CW_QUEUE;
        const int mybatch = (2 * vcu) / G;
#pragma nounroll
        for (int pass = 0; pass < 2; ++pass) { const int b = (mybatch ^ pass) & 1;
            for (;;) {
                if (tid == 0) MISC[4] = __hip_atomic_fetch_add(qctr + 64 * b, 1u, __ATOMIC_RELAXED, __HIP_MEMORY_SCOPE_AGENT);
                __syncthreads();
                const int it = __builtin_amdgcn_readfirstlane((int)MISC[4]);
                if (it >= 384) break;
                if (it >= 64 && it < 320) { const int ib = it - 64; att::unit_B(b, ib >> 5, ib & 31, bfast, QB, KB, VB, GB, Y, (LAS char*)lds); }
                else { const int h = it < 32 ? 3 : it < 64 ? 2 : it < 352 ? 1 : 0, qb = it & 31;
                    att::unit_A(b, h, qb, QA, KA, VA, GA, Y, a.subln_w, a.lq1, a.lk1, a.lq2, a.lk2, (const unsigned*)(wsp_ + WS_CTL) + CW_KMAX, scr, (LAS char*)lds); }
            }
            __syncthreads();
        }
    }
    SEAM(4);
    if (IN(5)) { WS_PTRS();
        pg8::Gemm g{Y, WOUT, M, DM, DM}; pg8::StaticOrder S; S.init(M, DM, G, bx);
        pg8::EpiOut E{a.x, a.out, modf};
        pg8::gemm_phase<pg8::EpiOut, pg8::StaticOrder, true, true>(lds, g, S, E);
    }
    SEAM(5);
    if (IN(6)) { WS_PTRS();
        for (int row = gw; row < M; row += NGW) {
            f32x4* xr = (f32x4*)(a.out + (size_t)row * DM) + lane; f32x4 v[4]; float s = 0.f;
#pragma unroll
            for (int j = 0; j < 4; ++j) { v[j] = xr[64 * j]; s += (v[j].x * v[j].x + v[j].y * v[j].y) + (v[j].z * v[j].z + v[j].w * v[j].w); }
            const float rstd = __builtin_amdgcn_rsqf(wave_sum(s) * (1.f / DM) + NORM_EPS);
#pragma unroll
            for (int j = 0; j < 4; ++j) { const f32x4 w = *((const f32x4*)a.fn_w + lane + 64 * j); xr[64 * j] = v[j] * rstd * w; }
        }
    }
#undef IN
#undef SEAM
}

extern "C" void kernel_launch(void* const* d_in, const int* in_sizes, int n_in, void* d_out, int out_size, void* d_ws, size_t ws_size, hipStream_t stream) {
    static int grid = 0;
    if (grid == 0) {
        if (n_in != 15 || in_sizes[0] != M * DM || out_size != M * DM || ws_size < WS_END) { fprintf(stderr, "kernel_launch: unexpected shapes (n_in %d, in0 %d, out %d, ws %zu)\n", n_in, n_in > 0 ? in_sizes[0] : -1, out_size, ws_size); grid = -1; return; }
        int dev = 0, cus = 0, per_cu = 0;
        hipGetDevice(&dev); hipDeviceGetAttribute(&cus, hipDeviceAttributeMultiprocessorCount, dev);
        if (hipFuncSetAttribute((const void*)mega, hipFuncAttributeMaxDynamicSharedMemorySize, LDS_BYTES) != hipSuccess) { fprintf(stderr, "kernel_launch: hipFuncSetAttribute failed\n"); grid = -1; return; }
        if (hipOccupancyMaxActiveBlocksPerMultiprocessor(&per_cu, (const void*)mega, NWAVES * 64, LDS_BYTES) != hipSuccess || per_cu < 1) { fprintf(stderr, "kernel_launch: occupancy query failed (%d)\n", per_cu); (void)hipGetLastError(); per_cu = 1; }
        grid = cus * per_cu; if (grid > 256) grid = 256;
    }
    if (grid < 0) return;
    Args a{};
    a.x = (const float*)d_in[0]; a.c = (const float*)d_in[1]; a.w_ada = (const float*)d_in[2]; a.b_ada = (const float*)d_in[3]; a.norm_w = (const float*)d_in[4]; a.w_in = (const float*)d_in[5];
    a.lq1 = (const float*)d_in[6]; a.lk1 = (const float*)d_in[7]; a.lq2 = (const float*)d_in[8]; a.lk2 = (const float*)d_in[9]; a.subln_w = (const float*)d_in[10];
    a.qn_w = (const float*)d_in[11]; a.kn_w = (const float*)d_in[12]; a.w_out = (const float*)d_in[13]; a.fn_w = (const float*)d_in[14];
    a.out = (float*)d_out; a.ws = (unsigned char*)d_ws; a.ph_lo = 0; a.ph_hi = 7;
    if (hipMemsetAsync((char*)d_ws + WS_CTL, 0, CTL_ZERO_BYTES, stream) != hipSuccess) { fprintf(stderr, "kernel_launch: hipMemsetAsync failed\n"); return; }
    hipLaunchKernelGGL(mega, dim3(grid), dim3(NWAVES * 64), LDS_BYTES, stream, a);
    const hipError_t e = hipPeekAtLastError();
    if (e != hipSuccess) fprintf(stderr, "kernel_launch: launch failed: %s (grid %d)\n", hipGetErrorName(e), grid);
}
```
